# Optimizing an MI355X kernel written in HIP

```python
import jax, jax.numpy as jnp
from jax import lax
import numpy as np

D_MODEL = 1024
BATCH = 8
SEQ = 2048
DEPTH = 4

HEAD_DIM = 64
A_HEADS = 8
A_WIDTH = A_HEADS * HEAD_DIM
B_WIDTH = 512
C_GROUPS = 4
C_WIDTH = 512
D_HEADS = 8
D_WIDTH = D_HEADS * HEAD_DIM
MOBA_BLOCK = 256
MOBA_TOPK = 3
MOBA_Q_CHUNK = 128
CONV_K = 31
SGU_CHUNK = 128
SB_Q_BLOCK = 128
D_FF = 2816
ROPE_THETA = 10000.0
RMS_EPS = 1e-6
LN_EPS = 1e-5
N_EVEN = (DEPTH + 1) // 2
N_ODD = DEPTH // 2
AB_IN = 3 * A_WIDTH + 2 * B_WIDTH
CD_IN = 2 * C_WIDTH + 3 * D_WIDTH

kernel_name = "hybrid_moba_conv_gmlp_stickbreak_trunk"


def rmsnorm(x, g):
    xf = x.astype(jnp.float32)
    y = xf * lax.rsqrt(jnp.mean(xf * xf, axis=-1, keepdims=True) + RMS_EPS)
    return (y * g.astype(jnp.float32)).astype(x.dtype)


def layernorm(x, g, b):
    xf = x.astype(jnp.float32)
    mu = jnp.mean(xf, axis=-1, keepdims=True)
    var = jnp.mean(jnp.square(xf - mu), axis=-1, keepdims=True)
    y = (xf - mu) * lax.rsqrt(var + LN_EPS)
    return (y * g.astype(jnp.float32) + b.astype(jnp.float32)).astype(x.dtype)


def swiglu(h, w_gate, w_up, w_down):
    return (jax.nn.silu(h @ w_gate) * (h @ w_up)) @ w_down


def rope_tables(seq):
    pos = jnp.arange(seq, dtype=jnp.float32)
    inv = ROPE_THETA ** (-jnp.arange(0, HEAD_DIM, 2, dtype=jnp.float32) / HEAD_DIM)
    ang = pos[:, None] * inv[None, :]
    return jnp.cos(ang), jnp.sin(ang)


def apply_rope(x, cos, sin):
    half = HEAD_DIM // 2
    xf = x.astype(jnp.float32)
    x1, x2 = xf[..., :half], xf[..., half:]
    c, s = cos[None, :, None, :], sin[None, :, None, :]
    return jnp.concatenate([x1 * c - x2 * s, x2 * c + x1 * s], axis=-1).astype(x.dtype)


def moba_attention(q, k, v):
    bsz, seq, nh, dh = q.shape
    n_blk = -(-seq // MOBA_BLOCK)
    pad = n_blk * MOBA_BLOCK - seq
    kp = jnp.pad(k, ((0, 0), (0, pad), (0, 0), (0, 0)))
    vp = jnp.pad(v, ((0, 0), (0, pad), (0, 0), (0, 0)))
    k_blocks = kp.reshape(bsz, n_blk, MOBA_BLOCK, nh, dh).transpose(0, 3, 1, 2, 4)
    v_blocks = vp.reshape(bsz, n_blk, MOBA_BLOCK, nh, dh).transpose(0, 3, 1, 2, 4)
    k_mean = jnp.mean(k_blocks.astype(jnp.float32), axis=3).astype(k.dtype)
    qh = q.transpose(0, 2, 1, 3)
    n_qc = seq // MOBA_Q_CHUNK
    top = min(MOBA_TOPK, n_blk)
    scale = HEAD_DIM ** -0.5
    blk_ids = jnp.arange(n_blk)
    gather_blocks = jax.vmap(lambda kb_h, idx_h: kb_h[idx_h])

    def one_chunk(bc):
        b, c = bc
        start = c * MOBA_Q_CHUNK
        q_c = lax.dynamic_slice_in_dim(qh[b], start, MOBA_Q_CHUNK, axis=1)
        kb, vb = k_blocks[b], v_blocks[b]
        own = start // MOBA_BLOCK
        q_pos = start + jnp.arange(MOBA_Q_CHUNK)
        gate = jnp.einsum('hqd,hnd->hqn', q_c, k_mean[b]).astype(jnp.float32)
        gate = jnp.where(blk_ids[None, None, :] < own, gate, -jnp.inf)
        _, idx = lax.top_k(gate, top)
        valid = idx < own
        k_sel = gather_blocks(kb, idx)
        v_sel = gather_blocks(vb, idx)
        s_sel = jnp.einsum('hqd,hqjpd->hqjp', q_c, k_sel).astype(jnp.float32) * scale
        s_sel = jnp.where(valid[..., None], s_sel, -jnp.inf).reshape(nh, MOBA_Q_CHUNK, top * MOBA_BLOCK)
        k_own = lax.dynamic_index_in_dim(kb, own, axis=1, keepdims=False)
        v_own = lax.dynamic_index_in_dim(vb, own, axis=1, keepdims=False)
        s_own = jnp.einsum('hqd,hpd->hqp', q_c, k_own).astype(jnp.float32) * scale
        key_pos = own * MOBA_BLOCK + jnp.arange(MOBA_BLOCK)
        s_own = jnp.where(key_pos[None, None, :] <= q_pos[None, :, None], s_own, -jnp.inf)
        p = jax.nn.softmax(jnp.concatenate([s_sel, s_own], axis=-1), axis=-1).astype(v.dtype)
        p_sel = p[..., :top * MOBA_BLOCK].reshape(nh, MOBA_Q_CHUNK, top, MOBA_BLOCK)
        p_own = p[..., top * MOBA_BLOCK:]
        return (jnp.einsum('hqjp,hqjpd->hqd', p_sel, v_sel)
                + jnp.einsum('hqp,hpd->hqd', p_own, v_own))

    b_ids = jnp.repeat(jnp.arange(bsz), n_qc)
    c_ids = jnp.tile(jnp.arange(n_qc), bsz)
    o = lax.map(one_chunk, (b_ids, c_ids))
    o = o.reshape(bsz, n_qc, nh, MOBA_Q_CHUNK, dh).transpose(0, 1, 3, 2, 4)
    return o.reshape(bsz, seq, nh * dh)


def conformer_conv(a, g, conv_w, conv_b, ln_g, ln_b):
    h = a * jax.nn.sigmoid(g)
    h = lax.conv_general_dilated(
        h, conv_w[:, None, :].astype(h.dtype), window_strides=(1,),
        padding=[(CONV_K - 1, 0)], dimension_numbers=('NWC', 'WIO', 'NWC'),
        feature_group_count=B_WIDTH) + conv_b
    return jax.nn.silu(layernorm(h, ln_g, ln_b))


def chunked_sgu(u, v, ln_g, ln_b, w_s, b_s):
    u = jax.nn.gelu(u)
    v = layernorm(jax.nn.gelu(v), ln_g, ln_b)
    bsz, seq, ch = v.shape
    vg = v.reshape(bsz, seq // SGU_CHUNK, SGU_CHUNK, C_GROUPS, ch // C_GROUPS)
    causal = jnp.tril(jnp.ones((SGU_CHUNK, SGU_CHUNK), dtype=w_s.dtype))
    mixed = jnp.einsum('gts,bnsgc->bntgc', w_s * causal, vg) + b_s.T[None, None, :, :, None]
    return u * mixed.reshape(bsz, seq, ch)


def stick_breaking_attention(q, k, v):
    bsz, seq, nh, dh = q.shape
    qh, kh, vh = (t.transpose(0, 2, 1, 3) for t in (q, k, v))
    scale = HEAD_DIM ** -0.5
    s_pos = jnp.arange(seq)
    n_qb = seq // SB_Q_BLOCK

    def one_block(i):
        start = i * SB_Q_BLOCK
        qb = lax.dynamic_slice_in_dim(qh, start, SB_Q_BLOCK, axis=2)
        z = jnp.einsum('bhqd,bhkd->bhqk', qb, kh).astype(jnp.float32) * scale
        t_pos = start + jnp.arange(SB_Q_BLOCK)
        strict = s_pos[None, :] < t_pos[:, None]
        log_1m = jnp.where(strict, jax.nn.log_sigmoid(-z), 0.0)
        after = lax.cumsum(log_1m, axis=3, reverse=True) - log_1m
        log_a = jnp.where(strict, jax.nn.log_sigmoid(z) + after, -jnp.inf)
        att = jnp.exp(log_a).astype(v.dtype)
        return jnp.einsum('bhqk,bhkd->bhqd', att, vh)

    o = lax.map(one_block, jnp.arange(n_qb))
    return o.transpose(1, 0, 3, 2, 4).reshape(bsz, seq, nh * dh)


def even_mixer(h, w_in, w_out, conv_w, conv_b, ln_g, ln_b, cos, sin):
    bsz, seq, _ = h.shape
    proj = h @ w_in
    q, k, v, ga, gb = jnp.split(proj, [A_WIDTH, 2 * A_WIDTH, 3 * A_WIDTH, 3 * A_WIDTH + B_WIDTH], axis=-1)
    q = apply_rope(q.reshape(bsz, seq, A_HEADS, HEAD_DIM), cos, sin)
    k = apply_rope(k.reshape(bsz, seq, A_HEADS, HEAD_DIM), cos, sin)
    v = v.reshape(bsz, seq, A_HEADS, HEAD_DIM)
    o_a = moba_attention(q, k, v)
    o_b = conformer_conv(ga, gb, conv_w, conv_b, ln_g, ln_b)
    return jnp.concatenate([o_a, o_b], axis=-1) @ w_out


def odd_mixer(h, w_in, w_out, ln_g, ln_b, w_s, b_s):
    bsz, seq, _ = h.shape
    proj = h @ w_in
    u, vc, q, k, v = jnp.split(proj, [C_WIDTH, 2 * C_WIDTH, 2 * C_WIDTH + D_WIDTH, 2 * C_WIDTH + 2 * D_WIDTH], axis=-1)
    o_c = chunked_sgu(u, vc, ln_g, ln_b, w_s, b_s)
    o_d = stick_breaking_attention(q.reshape(bsz, seq, D_HEADS, HEAD_DIM),
                                   k.reshape(bsz, seq, D_HEADS, HEAD_DIM),
                                   v.reshape(bsz, seq, D_HEADS, HEAD_DIM))
    return jnp.concatenate([o_c, o_d], axis=-1) @ w_out


def setup_inputs(seed: int = 0) -> dict:
    key = jax.random.key(seed)
    ks = jax.random.split(key, 17)
    f32 = jnp.float32
    nrm = lambda k, shape, s: jax.random.normal(k, shape, f32) * s
    return {
        'x': jax.random.normal(ks[0], (BATCH, SEQ, D_MODEL), f32),
        'norm_g': 1.0 + nrm(ks[1], (DEPTH, 6, D_MODEL), 0.02),
        'ffn_w_gate': nrm(ks[2], (DEPTH, 2, D_MODEL, D_FF), D_MODEL ** -0.5),
        'ffn_w_up': nrm(ks[3], (DEPTH, 2, D_MODEL, D_FF), D_MODEL ** -0.5),
        'ffn_w_down': nrm(ks[4], (DEPTH, 2, D_FF, D_MODEL), D_FF ** -0.5),
        'ab_w_in': nrm(ks[5], (N_EVEN, D_MODEL, AB_IN), D_MODEL ** -0.5),
        'ab_w_out': nrm(ks[6], (N_EVEN, A_WIDTH + B_WIDTH, D_MODEL), (A_WIDTH + B_WIDTH) ** -0.5),
        'conv_w': nrm(ks[7], (N_EVEN, CONV_K, B_WIDTH), CONV_K ** -0.5),
        'conv_b': nrm(ks[8], (N_EVEN, B_WIDTH), 0.02),
        'conv_ln_g': 1.0 + nrm(ks[9], (N_EVEN, B_WIDTH), 0.02),
        'conv_ln_b': nrm(ks[10], (N_EVEN, B_WIDTH), 0.02),
        'cd_w_in': nrm(ks[11], (N_ODD, D_MODEL, CD_IN), D_MODEL ** -0.5),
        'cd_w_out': nrm(ks[12], (N_ODD, C_WIDTH + D_WIDTH, D_MODEL), (C_WIDTH + D_WIDTH) ** -0.5),
        'sgu_ln_g': 1.0 + nrm(ks[13], (N_ODD, C_WIDTH), 0.02),
        'sgu_ln_b': nrm(ks[14], (N_ODD, C_WIDTH), 0.02),
        'sgu_w': nrm(ks[15], (N_ODD, C_GROUPS, SGU_CHUNK, SGU_CHUNK), SGU_CHUNK ** -0.5),
        'sgu_b': 1.0 + nrm(ks[16], (N_ODD, C_GROUPS, SGU_CHUNK), 0.02),
    }


def reference(x, norm_g, ffn_w_gate, ffn_w_up, ffn_w_down, ab_w_in, ab_w_out,
              conv_w, conv_b, conv_ln_g, conv_ln_b, cd_w_in, cd_w_out,
              sgu_ln_g, sgu_ln_b, sgu_w, sgu_b):
    seq = x.shape[1]
    cos, sin = rope_tables(seq)
    for layer in range(DEPTH):
        g = norm_g[layer]
        f = swiglu(rmsnorm(x, g[0]), ffn_w_gate[layer, 0], ffn_w_up[layer, 0], ffn_w_down[layer, 0])
        x = x + 0.5 * rmsnorm(f, g[1])
        h = rmsnorm(x, g[2])
        i = layer // 2
        if layer % 2 == 0:
            m = even_mixer(h, ab_w_in[i], ab_w_out[i], conv_w[i], conv_b[i],
                           conv_ln_g[i], conv_ln_b[i], cos, sin)
        else:
            m = odd_mixer(h, cd_w_in[i], cd_w_out[i], sgu_ln_g[i], sgu_ln_b[i], sgu_w[i], sgu_b[i])
        x = x + rmsnorm(m, g[3])
        f = swiglu(rmsnorm(x, g[4]), ffn_w_gate[layer, 1], ffn_w_up[layer, 1], ffn_w_down[layer, 1])
        x = x + 0.5 * rmsnorm(f, g[5])
    return x
```

```cpp
#include <hip/hip_runtime.h>
#include <hip/hip_cooperative_groups.h>
#include <cstdio>
#include <cstdint>
#include <cmath>
namespace cg = cooperative_groups;

#define LAS __attribute__((address_space(3)))
typedef float f32x2_t __attribute__((ext_vector_type(2)));
typedef __bf16 bf16x2_t __attribute__((ext_vector_type(2)));
__device__ __forceinline__ unsigned cvtpk(float lo, float hi) { f32x2_t v = {lo, hi}; bf16x2_t b = __builtin_convertvector(v, bf16x2_t); return __builtin_bit_cast(unsigned, b); }
__device__ __forceinline__ float bflo(unsigned u) { return __uint_as_float(u << 16); }
__device__ __forceinline__ float bfhi(unsigned u) { return __uint_as_float(u & 0xffff0000u); }
__device__ __forceinline__ float bf2f(unsigned short b) { return __uint_as_float((unsigned)b << 16); }
__device__ __forceinline__ float fexp2(float x) { return __builtin_amdgcn_exp2f(x); }
__device__ __forceinline__ float flog2(float x) { return __builtin_amdgcn_logf(x); }
__device__ __forceinline__ float frcp(float x) { return __builtin_amdgcn_rcpf(x); }
__device__ __forceinline__ float sigmoidf_(float x) { return frcp(1.0f + fexp2(-1.4426950408889634f * x)); }
__device__ __forceinline__ float siluf_(float x) { return x * sigmoidf_(x); }
__device__ __forceinline__ float geluf_(float x) { const float y = 0.7978845608028654f * (x + 0.044715f * x * x * x); return x * sigmoidf_(2.0f * y); }

__device__ __forceinline__ float shx(float v, int o, int lane) { return __builtin_bit_cast(float, __builtin_amdgcn_ds_bpermute((lane ^ o) << 2, __builtin_bit_cast(int, v))); }
namespace pg8 {
#define PG8_LAS __attribute__((address_space(3)))
typedef unsigned short bf16_t;
typedef short bf16x8 __attribute__((ext_vector_type(8)));
typedef float f32x4 __attribute__((ext_vector_type(4)));
typedef unsigned u32x4 __attribute__((ext_vector_type(4)));
constexpr int BM = 256, BK = 64, HALF = 128, HTB = HALF * BK * 2  , STAGE_BYTES = 8 * HTB, NXCD = 8, WGM = 8;

__host__ __device__ __forceinline__ int lds_byte(int r, int c) { const int st = (r >> 4) * 2 + (c >> 5), rr = r & 15, cc = c & 31, ob = rr * 64 + cc * 2; return st * 1024 + (ob ^ (((ob >> 9) & 1) << 5)); }
__host__ __device__ __forceinline__ void stage_rc(int b, int& R, int& C) { const int st = b / 1024, sb = b % 1024, swz = sb ^ (((sb >> 9) & 1) << 5); R = (st >> 1) * 16 + swz / 64; C = (st & 1) * 32 + (swz % 64) / 2; }
__host__ __device__ __forceinline__ int perm32(int rho) { const int n = rho >> 4, i = rho & 15; return 8 * (i >> 2) + 4 * n + (i & 3); }

struct Unit { int pm, pn; };
struct Gemm { const bf16_t* A; const bf16_t* Bt; int M, N, K; };

struct StaticOrder {
    int nM, nN, nwg, G, c;
    __host__ __device__ void init(int M, int N, int G_, int c_) { nM = M / BM; nN = N / BM; nwg = nM * nN; G = G_; c = c_; }
    __host__ __device__ bool next(int i, Unit& u) const {
        const long L = (long)i * G + c; if (L >= nwg) return false;
        int wgid = (int)L; { const int q = nwg / NXCD, r = nwg % NXCD, xcd = wgid % NXCD, off = wgid / NXCD; wgid = (xcd < r ? xcd * (q + 1) : r * (q + 1) + (xcd - r) * q) + off; }
        const int nig = WGM * nN, gid = wgid / nig, fm = gid * WGM, gsz = (nM - fm) < WGM ? (nM - fm) : WGM;
        u.pm = fm + ((wgid % nig) % gsz); u.pn = (wgid % nig) / gsz; return true;
    }
    __device__ __forceinline__ void a_ready(const Unit&) const {}
    __device__ __forceinline__ void done(const Unit&) const {}
};

__device__ __forceinline__ float silu_(float x) { return x * __builtin_amdgcn_rcpf(1.0f + __builtin_amdgcn_exp2f(-1.4426950408889634f * x)); }
struct EpiSwiGLU {
    static constexpr bool PERM = true, AFTER_DRAIN = false;
    bf16_t* O; int ldc;
    __device__ __forceinline__ void operator()(const f32x4 (&acc)[2][2][4][2], const Unit& u, int wr, int wc, int fr, int fq) const {
        const int row0 = u.pm * BM + wr * 64 + fr, col0 = u.pn * HALF + wc * 32 + 8 * fq;
#pragma unroll
        for (int ai = 0; ai < 2; ++ai)
#pragma unroll
            for (int m = 0; m < 4; ++m) { bf16_t* rowp = O + (size_t)(row0 + ai * HALF + m * 16) * ldc + col0;
                const f32x4 g0 = acc[ai][0][m][0], g1 = acc[ai][0][m][1], u0 = acc[ai][1][m][0], u1 = acc[ai][1][m][1];
                u32x4 w; w.x = cvtpk(silu_(g0[0]) * u0[0], silu_(g0[1]) * u0[1]); w.y = cvtpk(silu_(g0[2]) * u0[2], silu_(g0[3]) * u0[3]);
                w.z = cvtpk(silu_(g1[0]) * u1[0], silu_(g1[1]) * u1[1]); w.w = cvtpk(silu_(g1[2]) * u1[2], silu_(g1[3]) * u1[3]);
                *(u32x4*)rowp = w; asm volatile("" ::: "memory"); }
    }
};
template <bool ROPE> struct EpiBf16 {
    static constexpr bool PERM = true, AFTER_DRAIN = false;
    bf16_t* O; int ldc; const float* rope; int rope_cols;
    __device__ __forceinline__ void operator()(const f32x4 (&acc)[2][2][4][2], const Unit& u, int wr, int wc, int fr, int fq) const {
        const int row0 = u.pm * BM + wr * 64 + fr, col0 = u.pn * BM + wc * 32 + 8 * fq;
        const bool dorope = ROPE && (u.pn * BM < rope_cols);
#pragma unroll
        for (int ai = 0; ai < 2; ++ai) {
            f32x4 rc0[4], rc1[4];
#pragma unroll
            for (int m = 0; m < 4; ++m) { rc0[m] = (f32x4){1.f, 0.f, 1.f, 0.f}; rc1[m] = (f32x4){1.f, 0.f, 1.f, 0.f};
                if (ROPE) { if (dorope) { const int row = row0 + ai * HALF + m * 16; const f32x4* rp = (const f32x4*)(rope + ((size_t)(row & 2047) * 32 + 16 * (wc & 1) + 4 * fq) * 2); rc0[m] = rp[0]; rc1[m] = rp[1]; } } }
#pragma unroll
            for (int m = 0; m < 4; ++m) { const int row = row0 + ai * HALF + m * 16; bf16_t* rowp = O + (size_t)row * ldc + col0;
                const f32x4 c0 = rc0[m], c1 = rc1[m];
#pragma unroll
                for (int bj = 0; bj < 2; ++bj) { f32x4 v0 = acc[ai][bj][m][0], v1 = acc[ai][bj][m][1];
                    if (ROPE) { const f32x4 a = v0, b = v1;
                        v0[0] = a[0] * c0[0] - a[1] * c0[1]; v0[1] = a[1] * c0[0] + a[0] * c0[1]; v0[2] = a[2] * c0[2] - a[3] * c0[3]; v0[3] = a[3] * c0[2] + a[2] * c0[3];
                        v1[0] = b[0] * c1[0] - b[1] * c1[1]; v1[1] = b[1] * c1[0] + b[0] * c1[1]; v1[2] = b[2] * c1[2] - b[3] * c1[3]; v1[3] = b[3] * c1[2] + b[2] * c1[3]; }
                    u32x4 w; w.x = cvtpk(v0[0], v0[1]); w.y = cvtpk(v0[2], v0[3]); w.z = cvtpk(v1[0], v1[1]); w.w = cvtpk(v1[2], v1[3]);
                    *(u32x4*)(rowp + bj * HALF) = w; }
                asm volatile("" ::: "memory"); } }
    }
};


__device__ __forceinline__ void panel_ss(const f32x4 (&v)[2][2][4][2], const Unit& u, int wr, int wc, int fr, int fq, PG8_LAS unsigned char* lds, int wid, int lane, float* slots, unsigned* cnt, unsigned target) {
    PG8_LAS float* P = (PG8_LAS float*)lds; PG8_LAS float* S = (PG8_LAS float*)(lds + 4096);
#pragma unroll
    for (int ai = 0; ai < 2; ++ai)
#pragma unroll
        for (int m = 0; m < 4; ++m) { float s = 0.f;
#pragma unroll
            for (int bj = 0; bj < 2; ++bj)
#pragma unroll
                for (int n = 0; n < 2; ++n) { const f32x4 x = v[ai][bj][m][n]; s += (x[0] * x[0] + x[1] * x[1]) + (x[2] * x[2] + x[3] * x[3]); }
            s += shx(s, 16, lane); s += shx(s, 32, lane);
            if (fq == 0) P[(ai * HALF + wr * 64 + m * 16 + fr) * 4 + wc] = s; }
    asm volatile("s_waitcnt lgkmcnt(0)" ::: "memory"); __builtin_amdgcn_s_barrier(); asm volatile("" ::: "memory");
    const int row = wid * 32 + (lane & 31);
    if (lane < 32) { const f32x4 a = *(const PG8_LAS f32x4*)(P + row * 4); const float t = (a[0] + a[1]) + (a[2] + a[3]);
        __hip_atomic_store(slots + (size_t)(u.pm * BM + row) * 4 + u.pn, t, __ATOMIC_RELAXED, __HIP_MEMORY_SCOPE_AGENT); }
    asm volatile("s_waitcnt vmcnt(0)" ::: "memory");
    if (lane == 0) __hip_atomic_fetch_add(cnt + 64 * u.pm, 1u, __ATOMIC_RELAXED, __HIP_MEMORY_SCOPE_AGENT);
    if (wid == 0) { unsigned sp = 0;
        while ((unsigned)__builtin_amdgcn_readfirstlane(__hip_atomic_load(cnt + 64 * u.pm, __ATOMIC_RELAXED, __HIP_MEMORY_SCOPE_AGENT)) < target) { __builtin_amdgcn_s_sleep(2); if (++sp > (1u << 22)) break; }
        __builtin_amdgcn_fence(__ATOMIC_ACQUIRE, "agent"); }
    asm volatile("s_waitcnt vmcnt(0) lgkmcnt(0)" ::: "memory"); __builtin_amdgcn_s_barrier(); asm volatile("" ::: "memory");
    if (lane < 32) { const float* sl = slots + (size_t)(u.pm * BM + row) * 4; float t = 0.f;
#pragma unroll
        for (int q = 0; q < 4; ++q) t += __hip_atomic_load(sl + q, __ATOMIC_RELAXED, __HIP_MEMORY_SCOPE_AGENT);
        S[row] = t; }
    asm volatile("s_waitcnt lgkmcnt(0)" ::: "memory"); __builtin_amdgcn_s_barrier(); asm volatile("" ::: "memory");
}
__device__ __forceinline__ void unpack8(const u32x4 w, f32x4& a, f32x4& b) { a = (f32x4){__uint_as_float(w.x << 16), __uint_as_float(w.x & 0xffff0000u), __uint_as_float(w.y << 16), __uint_as_float(w.y & 0xffff0000u)};
    b = (f32x4){__uint_as_float(w.z << 16), __uint_as_float(w.z & 0xffff0000u), __uint_as_float(w.w << 16), __uint_as_float(w.w & 0xffff0000u)}; }
struct FusedNorm {
    bf16_t* xb; bf16_t* xn; float* fout; const float* g_post; const float* g_pre; float coef; float* slots1; float* slots2; unsigned* cnt1; unsigned* cnt2; unsigned target;
    __device__ __forceinline__ void run(f32x4 (&acc)[2][2][4][2], const Unit& u, int wr, int wc, int fr, int fq, PG8_LAS unsigned char* lds, int wid, int lane) const {
        const PG8_LAS float* S = (const PG8_LAS float*)(lds + 4096);
        const int col0 = u.pn * BM + wc * 32 + 8 * fq;
        u32x4 pre[2][4][2];
#pragma unroll
        for (int ai = 0; ai < 2; ++ai)
#pragma unroll
            for (int m = 0; m < 4; ++m) { const size_t off = (size_t)(u.pm * BM + ai * HALF + wr * 64 + m * 16 + fr) * 1024 + col0;
#pragma unroll
                for (int bj = 0; bj < 2; ++bj) pre[ai][m][bj] = *(const u32x4*)(xb + off + bj * HALF); }
        panel_ss(acc, u, wr, wc, fr, fq, lds, wid, lane, slots1, cnt1, target);
        { f32x4 g[2][2];
#pragma unroll
          for (int bj = 0; bj < 2; ++bj)
#pragma unroll
              for (int n = 0; n < 2; ++n) g[bj][n] = *(const f32x4*)(g_post + col0 + bj * HALF + 4 * n);
#pragma unroll
          for (int ai = 0; ai < 2; ++ai)
#pragma unroll
              for (int m = 0; m < 4; ++m) { const int r = ai * HALF + wr * 64 + m * 16 + fr; const float rs = coef / sqrtf(S[r] * (1.0f / 1024.0f) + 1e-6f);
#pragma unroll
                  for (int bj = 0; bj < 2; ++bj) { f32x4 x0, x1; unpack8(pre[ai][m][bj], x0, x1);
                      acc[ai][bj][m][0] = x0 + acc[ai][bj][m][0] * g[bj][0] * rs; acc[ai][bj][m][1] = x1 + acc[ai][bj][m][1] * g[bj][1] * rs; } } }
        if (!fout) panel_ss(acc, u, wr, wc, fr, fq, lds, wid, lane, slots2, cnt2, target);
        { f32x4 g[2][2];
#pragma unroll
          for (int bj = 0; bj < 2; ++bj)
#pragma unroll
              for (int n = 0; n < 2; ++n) g[bj][n] = fout ? (f32x4){0.f, 0.f, 0.f, 0.f} : *(const f32x4*)(g_pre + col0 + bj * HALF + 4 * n);
#pragma unroll
          for (int ai = 0; ai < 2; ++ai)
#pragma unroll
              for (int m = 0; m < 4; ++m) { const int r = ai * HALF + wr * 64 + m * 16 + fr; const float rs = 1.0f / sqrtf(S[r] * (1.0f / 1024.0f) + 1e-6f);
                  const size_t off = (size_t)(u.pm * BM + r) * 1024 + col0;
#pragma unroll
                  for (int bj = 0; bj < 2; ++bj) { const f32x4 v0 = acc[ai][bj][m][0], v1 = acc[ai][bj][m][1];
                      if (fout) { *(f32x4*)(fout + off + bj * HALF) = v0; *(f32x4*)(fout + off + bj * HALF + 4) = v1; }
                      else { u32x4 wx; wx.x = cvtpk(v0[0], v0[1]); wx.y = cvtpk(v0[2], v0[3]); wx.z = cvtpk(v1[0], v1[1]); wx.w = cvtpk(v1[2], v1[3]);
                          *(u32x4*)(xb + off + bj * HALF) = wx;
                          const f32x4 y0 = v0 * g[bj][0] * rs, y1 = v1 * g[bj][1] * rs; u32x4 w; w.x = cvtpk(y0[0], y0[1]); w.y = cvtpk(y0[2], y0[3]); w.z = cvtpk(y1[0], y1[1]); w.w = cvtpk(y1[2], y1[3]);
                          *(u32x4*)(xn + off + bj * HALF) = w; } }
                  asm volatile("" ::: "memory"); } }
    }
};
struct EpiUni {
    static constexpr bool PERM = true, AFTER_DRAIN = false;
    bf16_t* O; int ldc; const float* rope; int rope_cols; int swiglu; int fused_mode; FusedNorm fn;
    __device__ __forceinline__ void operator()(const f32x4 (&acc)[2][2][4][2], const Unit& u, int wr, int wc, int fr, int fq) const {
        if (swiglu) { EpiSwiGLU e{O, ldc}; e(acc, u, wr, wc, fr, fq); }
        else { EpiBf16<true> e{O, ldc, rope, rope_cols}; e(acc, u, wr, wc, fr, fq); }
    }
    __device__ __forceinline__ void fused(f32x4 (&acc)[2][2][4][2], const Unit& u, int wr, int wc, int fr, int fq, PG8_LAS unsigned char* lds, int wid, int lane) const { fn.run(acc, u, wr, wc, fr, fq, lds, wid, lane); }
};
template <class Epi, class Sched, bool ALIGN_EPI = false, bool SP2 = false>
__device__ __forceinline__ void gemm_phase(PG8_LAS unsigned char* lds, const Gemm g, const Sched& S, const Epi& E, const int tid_in) {
    const int tid = tid_in, wid = __builtin_amdgcn_readfirstlane(tid >> 6), lane = tid & 63, wr = wid >> 2, wc = wid & 3, fr = lane & 15, fq = lane >> 4;
    const int K = g.K, nt = K / BK;
    unsigned voffA[2], voffB[2];
#pragma unroll
    for (int i = 0; i < 2; ++i) { int R, C; stage_rc(tid * 16 + i * 8192, R, C); const int Rb = Epi::PERM ? ((R & ~31) + perm32(R & 31)) : R;
        voffA[i] = (unsigned)(R * K + C) * 2u; voffB[i] = (unsigned)(Rb * K + C) * 2u; }
    const size_t kstep = (size_t)(BK * 2);
    const size_t hstep = (size_t)HALF * K * 2;
    const size_t tstep = 2 * hstep;
    const unsigned ldsw = (unsigned)wid * 1024u;
    const int aoff = lds_byte(wr * 64 + fr, fq * 8), boff = lds_byte(wc * 32 + fr, fq * 8);
#define PG8_SA(b, h) (((b) * 2 + (h)) * HTB)
#define PG8_SB(b, h) ((4 + (b) * 2 + (h)) * HTB)
#define PG8_STAGE(bufoff, gbase, voff) do { _Pragma("unroll") for (int _i = 0; _i < 2; ++_i) \
        __builtin_amdgcn_global_load_lds((const unsigned*)((const char*)(gbase) + (voff)[_i]), (PG8_LAS unsigned*)(lds + (bufoff) + ldsw + _i * 8192), 16, 0, 0); } while (0)
#define PG8_LDA(dst, b, h) do { _Pragma("unroll") for (int m = 0; m < 4; ++m) _Pragma("unroll") for (int k = 0; k < 2; ++k) dst[m][k] = *(const PG8_LAS bf16x8*)(lds + PG8_SA(b, h) + aoff + m * 2048 + k * 1024); } while (0)
#define PG8_LDB(dst, b, h) do { _Pragma("unroll") for (int n = 0; n < 2; ++n) _Pragma("unroll") for (int k = 0; k < 2; ++k) dst[n][k] = *(const PG8_LAS bf16x8*)(lds + PG8_SB(b, h) + boff + n * 2048 + k * 1024); } while (0)
#define PG8_MMA(ai, bj, At, Bt) do { __builtin_amdgcn_s_setprio(1); _Pragma("unroll") for (int m = 0; m < 4; ++m) _Pragma("unroll") for (int n = 0; n < 2; ++n) _Pragma("unroll") for (int k = 0; k < 2; ++k) \
        acc[ai][bj][m][n] = __builtin_amdgcn_mfma_f32_16x16x32_bf16(Bt[n][k], At[m][k], acc[ai][bj][m][n], 0, 0, 0); __builtin_amdgcn_s_setprio(0); } while (0)
#define PG8_WAIT_V(n) asm volatile("s_waitcnt vmcnt(" #n ")" ::: "memory")
#define PG8_WAIT_L(n) asm volatile("s_waitcnt lgkmcnt(" #n ")" ::: "memory")
#define PG8_BAR __builtin_amdgcn_s_barrier()
#define PG8_SCHED __builtin_amdgcn_sched_barrier(0)
    Unit cur, nxt; int ui = 0;
    if (!S.next(0, cur)) return;
    f32x4 acc[2][2][4][2];
#pragma unroll
    for (int a = 0; a < 2; ++a)
#pragma unroll
        for (int b = 0; b < 2; ++b)
#pragma unroll
            for (int m = 0; m < 4; ++m)
#pragma unroll
                for (int n = 0; n < 2; ++n) acc[a][b][m][n] = (f32x4){0.f, 0.f, 0.f, 0.f};
    bf16x8 At[4][2], B0[2][2], B1[2][2];
    const char* cA = (const char*)g.A + (size_t)cur.pm * tstep; const char* cB = (const char*)g.Bt + (size_t)cur.pn * tstep;
    S.a_ready(cur);
    if constexpr (SP2) {
        PG8_STAGE(PG8_SB(0, 0), cB, voffB); PG8_STAGE(PG8_SB(0, 1), cB + hstep, voffB); PG8_STAGE(PG8_SA(0, 0), cA, voffA); PG8_STAGE(PG8_SA(0, 1), cA + hstep, voffA);
        if (wr == 1) PG8_BAR;
        PG8_WAIT_V(2); PG8_BAR;
        PG8_STAGE(PG8_SB(1, 0), cB + kstep, voffB); PG8_STAGE(PG8_SA(1, 0), cA + kstep, voffA); PG8_STAGE(PG8_SB(1, 1), cB + hstep + kstep, voffB);
        PG8_WAIT_V(6); PG8_BAR;
    } else {
        PG8_STAGE(PG8_SB(0, 0), cB, voffB); PG8_STAGE(PG8_SA(0, 0), cA, voffA); PG8_STAGE(PG8_SB(0, 1), cB + hstep, voffB); PG8_STAGE(PG8_SA(0, 1), cA + hstep, voffA);
        if (wr == 1) PG8_BAR;
        PG8_WAIT_V(4); PG8_BAR;
        PG8_STAGE(PG8_SB(1, 0), cB + kstep, voffB); PG8_STAGE(PG8_SA(1, 0), cA + kstep, voffA); PG8_STAGE(PG8_SB(1, 1), cB + hstep + kstep, voffB);
        PG8_WAIT_V(6); PG8_BAR;
    }
    for (;;) {
        const bool has_next = S.next(ui + 1, nxt);
        const char* nA = has_next ? (const char*)g.A + (size_t)nxt.pm * tstep : cA; const char* nB = has_next ? (const char*)g.Bt + (size_t)nxt.pn * tstep : cB;
        for (int t = 0; t < nt; t += 2) {
            const bool last = (t == nt - 2);
            const char* a1 = cA + (size_t)(t + 1) * kstep;
            const char* a2 = last ? nA : cA + (size_t)(t + 2) * kstep; const char* b2 = last ? nB : cB + (size_t)(t + 2) * kstep;
            const char* a3 = a2 + kstep; const char* b3 = b2 + kstep;
            if (last && has_next) S.a_ready(nxt);
            if constexpr (SP2) {
            PG8_LDB(B0, 0, 0); PG8_LDB(B1, 0, 1); PG8_SCHED; PG8_LDA(At, 0, 0); PG8_STAGE(PG8_SA(1, 1), a1 + hstep, voffA);
            PG8_WAIT_V(8); PG8_WAIT_L(0); PG8_BAR; PG8_MMA(0, 0, At, B0); PG8_MMA(0, 1, At, B1); PG8_BAR; PG8_SCHED;
            PG8_LDA(At, 0, 1); PG8_STAGE(PG8_SB(0, 0), b2, voffB); PG8_STAGE(PG8_SB(0, 1), b2 + hstep, voffB); PG8_STAGE(PG8_SA(0, 0), a2, voffA);
            PG8_WAIT_V(8); PG8_WAIT_L(0); PG8_BAR; PG8_MMA(1, 0, At, B0); PG8_MMA(1, 1, At, B1); PG8_BAR; PG8_SCHED;
            PG8_LDB(B0, 1, 0); PG8_LDB(B1, 1, 1); PG8_SCHED; PG8_LDA(At, 1, 0); PG8_STAGE(PG8_SA(0, 1), a2 + hstep, voffA);
            PG8_WAIT_V(8); PG8_WAIT_L(0); PG8_BAR; PG8_MMA(0, 0, At, B0); PG8_MMA(0, 1, At, B1); PG8_BAR; PG8_SCHED;
            PG8_LDA(At, 1, 1); PG8_STAGE(PG8_SB(1, 0), b3, voffB); PG8_STAGE(PG8_SB(1, 1), b3 + hstep, voffB); PG8_STAGE(PG8_SA(1, 0), a3, voffA);
            PG8_WAIT_V(8); PG8_WAIT_L(0); PG8_BAR; PG8_MMA(1, 0, At, B0); PG8_MMA(1, 1, At, B1); PG8_BAR; PG8_SCHED;
            } else {
            PG8_LDB(B0, 0, 0); PG8_SCHED; PG8_LDA(At, 0, 0); PG8_STAGE(PG8_SA(1, 1), a1 + hstep, voffA);
            PG8_WAIT_L(8); PG8_BAR; PG8_WAIT_L(0); PG8_MMA(0, 0, At, B0); PG8_BAR; PG8_SCHED;
            PG8_LDB(B1, 0, 1); PG8_STAGE(PG8_SB(0, 0), b2, voffB);
            PG8_BAR; PG8_WAIT_L(0); PG8_MMA(0, 1, At, B1); PG8_BAR;
            PG8_LDA(At, 0, 1); PG8_STAGE(PG8_SA(0, 0), a2, voffA);
            PG8_BAR; PG8_WAIT_L(0); PG8_MMA(1, 0, At, B0); PG8_BAR; PG8_SCHED;
            PG8_STAGE(PG8_SB(0, 1), b2 + hstep, voffB);
            PG8_WAIT_V(6); PG8_BAR; PG8_MMA(1, 1, At, B1); PG8_BAR;
            PG8_LDB(B0, 1, 0); PG8_SCHED; PG8_LDA(At, 1, 0); PG8_STAGE(PG8_SA(0, 1), a2 + hstep, voffA);
            PG8_WAIT_L(8); PG8_BAR; PG8_WAIT_L(0); PG8_MMA(0, 0, At, B0); PG8_BAR; PG8_SCHED;
            PG8_LDB(B1, 1, 1); PG8_STAGE(PG8_SB(1, 0), b3, voffB);
            PG8_BAR; PG8_WAIT_L(0); PG8_MMA(0, 1, At, B1); PG8_BAR;
            PG8_LDA(At, 1, 1); PG8_STAGE(PG8_SA(1, 0), a3, voffA);
            PG8_BAR; PG8_WAIT_L(0); PG8_MMA(1, 0, At, B0); PG8_BAR; PG8_SCHED;
            PG8_STAGE(PG8_SB(1, 1), b3 + hstep, voffB);
            PG8_WAIT_V(6); PG8_BAR; PG8_MMA(1, 1, At, B1); PG8_BAR;
            }
        }
        if constexpr (ALIGN_EPI) { if (wr == 0) PG8_BAR; }
        if (!E.fused_mode) { E(acc, cur, wr, wc, fr, fq); S.done(cur); }
        if (!has_next) break;
#pragma unroll
        for (int a = 0; a < 2; ++a)
#pragma unroll
            for (int b = 0; b < 2; ++b)
#pragma unroll
                for (int m = 0; m < 4; ++m)
#pragma unroll
                    for (int n = 0; n < 2; ++n) acc[a][b][m][n] = (f32x4){0.f, 0.f, 0.f, 0.f};
        cur = nxt; cA = nA; cB = nB; ++ui;
        if constexpr (ALIGN_EPI) { if (wr == 1) PG8_BAR; }
    }
    PG8_WAIT_V(0);
    if constexpr (!ALIGN_EPI) { if (wr == 0) PG8_BAR; }
    PG8_BAR;
    if (E.fused_mode) { E.fused(acc, cur, wr, wc, fr, fq, lds, wid, lane); S.done(cur); }
#undef PG8_SA
#undef PG8_SB
#undef PG8_STAGE
#undef PG8_LDA
#undef PG8_LDB
#undef PG8_MMA
#undef PG8_WAIT_V
#undef PG8_WAIT_L
#undef PG8_BAR
#undef PG8_SCHED
}
}

constexpr int D = 1024, SEQ = 2048, BATCH = 8, M = BATCH * SEQ, FF = 2816, NPROJ = 2560, DEPTH = 4;
constexpr int NWAVES = 8, NTHREADS = NWAVES * 64;
typedef unsigned short bf16;
typedef short bf16x8 __attribute__((ext_vector_type(8)));
typedef float f32x16 __attribute__((ext_vector_type(16)));
typedef float f32x4 __attribute__((ext_vector_type(4)));
typedef unsigned u32x4 __attribute__((ext_vector_type(4)));
typedef unsigned u32x2 __attribute__((ext_vector_type(2)));
typedef short s16x4 __attribute__((ext_vector_type(4)));
#define MFMA32(a, b, c) __builtin_amdgcn_mfma_f32_32x32x16_bf16((a), (b), (c), 0, 0, 0)

constexpr size_t MiB = 1u << 20;
constexpr size_t WL_GU0 = 0, WL_GU1 = 11534336, WL_D0 = 2 * 11534336, WL_D1 = WL_D0 + 5767168, WL_IN = WL_D1 + 5767168, WL_OUT = WL_IN + 5242880, WL_BYTES = 40 * MiB;
static_assert(WL_OUT + 2097152 == WL_BYTES, "per-layer weight block");
constexpr size_t WS_W = 0, WS_ROPE = 160 * MiB, WS_XN = 161 * MiB, WS_HB = 193 * MiB, WS_PROJ = WS_HB, WS_F = 281 * MiB, WS_MIX = 313 * MiB, WS_CTL = 345 * MiB, CTL_CNT1 = 16384, CTL_CNT2 = 32768, CTL_Q = 49152, CTL_BYTES = 53248, WS_SLOT1 = 346 * MiB, WS_SLOT2 = 347 * MiB, WS_END = 348 * MiB;

constexpr int LDS_BYTES = 147456;
constexpr int LDS_MISC = 131072 + 320;

__device__ __forceinline__ float wave_sum(float v, int lane) {
#pragma unroll
    for (int o = 1; o < 64; o <<= 1) v += shx(v, o, lane);
    return v;
}

template <int MODE> __device__ __forceinline__ int dest_row(int n, int row_off) {
    if (MODE == 1) return 256 * (n >> 7) + row_off + (n & 127);
    if (MODE == 2) { if (n >= 1024) return n; const int d = n & 63; return (n & ~63) + (d < 32 ? 2 * d : 2 * (d - 32) + 1); }
    return n + row_off;
}
template <int MODE> __device__ __forceinline__ void transpose_item(const float* W, int K, int N, bf16* WT, int row_off, LAS float* scr, int item, int lane) {
    const int nblk = N / 32, kb = item / nblk, nb = item % nblk, k0 = 64 * kb, n0 = 32 * nb;
    float wv[32];
#pragma unroll
    for (int i = 0; i < 32; ++i) wv[i] = __builtin_nontemporal_load(W + (size_t)(k0 + 2 * i + (lane >> 5)) * N + n0 + (lane & 31));
#pragma unroll
    for (int i = 0; i < 32; ++i) scr[(2 * i + (lane >> 5)) * 33 + (lane & 31)] = wv[i];
    asm volatile("s_waitcnt lgkmcnt(0)" ::: "memory");
    const int c = lane & 7;
#pragma unroll
    for (int j = 0; j < 4; ++j) { const int n = (lane >> 3) + 8 * j; const LAS float* s = scr + (8 * c) * 33 + n;
        u32x4 o; o.x = cvtpk(s[0 * 33], s[1 * 33]); o.y = cvtpk(s[2 * 33], s[3 * 33]); o.z = cvtpk(s[4 * 33], s[5 * 33]); o.w = cvtpk(s[6 * 33], s[7 * 33]);
        *(u32x4*)(WT + (size_t)dest_row<MODE>(n0 + n, row_off) * K + k0 + 8 * c) = o; }
    asm volatile("s_waitcnt lgkmcnt(0)" ::: "memory");
}

struct Params {
    const float* x; const float* norm_g; const float* w_gate; const float* w_up; const float* w_down;
    const float* ab_w_in; const float* ab_w_out; const float* conv_w; const float* conv_b; const float* conv_ln_g; const float* conv_ln_b;
    const float* cd_w_in; const float* cd_w_out; const float* sgu_ln_g; const float* sgu_ln_b; const float* sgu_w; const float* sgu_b;
    float* out; unsigned char* ws;
    int ph_lo, ph_hi;
    float inv_freq[32];
};

typedef const __attribute__((address_space(4))) Params* PP;
constexpr int CV_I_G = (D / 64) * (FF / 32), CV_I_D = (FF / 64) * (D / 32), CV_I_IN = (D / 64) * (NPROJ / 32), CV_I_OUT = (D / 64) * (D / 32);
constexpr int CV_PER_LAYER = 4 * CV_I_G + 2 * CV_I_D + CV_I_IN + CV_I_OUT;
__device__ __forceinline__ void convert_wave_item(PP p, int L, int r, LAS float* scr, int lane) {
    constexpr int I_G = CV_I_G, I_D = CV_I_D, I_IN = CV_I_IN;
    unsigned char* wl = p->ws + WS_W + (size_t)L * WL_BYTES;
    if (r < 4 * I_G) { const int f = r / (2 * I_G); r -= f * 2 * I_G; const int up = r / I_G; r -= up * I_G;
        const float* W = (up ? p->w_up : p->w_gate) + (size_t)(L * 2 + f) * D * FF;
        transpose_item<1>(W, D, FF, (bf16*)(wl + (f ? WL_GU1 : WL_GU0)), up ? 128 : 0, scr, r, lane); return; }
    r -= 4 * I_G;
    if (r < 2 * I_D) { const int f = r / I_D; r -= f * I_D;
        transpose_item<0>(p->w_down + (size_t)(L * 2 + f) * FF * D, FF, D, (bf16*)(wl + (f ? WL_D1 : WL_D0)), 0, scr, r, lane); return; }
    r -= 2 * I_D;
    const int i = L >> 1; const bool even = (L & 1) == 0;
    if (r < I_IN) { const float* W = (even ? p->ab_w_in : p->cd_w_in) + (size_t)i * D * NPROJ;
        if (even) transpose_item<2>(W, D, NPROJ, (bf16*)(wl + WL_IN), 0, scr, r, lane); else transpose_item<0>(W, D, NPROJ, (bf16*)(wl + WL_IN), 0, scr, r, lane); return; }
    r -= I_IN;
    transpose_item<0>((even ? p->ab_w_out : p->cd_w_out) + (size_t)i * D * D, D, D, (bf16*)(wl + WL_OUT), 0, scr, r, lane);
}
__device__ __forceinline__ void prologue_weights(PP p, LAS unsigned char* lds, int gw, int NGW, int wave, int lane) {
    LAS float* scr = (LAS float*)(lds + wave * 16384);
    const int nit = (NGW == 256 * NWAVES) ? 2816 : DEPTH * CV_PER_LAYER;
    for (int it = gw; it < nit; it += NGW) convert_wave_item(p, it / CV_PER_LAYER, it % CV_PER_LAYER, scr, lane);
}
__device__ __forceinline__ void prologue_rope(PP p, int gtid, int NGT) {
    float* tab = (float*)(p->ws + WS_ROPE);
    for (int e = gtid; e < SEQ * 32; e += NGT) { const int pos = e >> 5, i = e & 31;
        const float ang = (float)pos * p->inv_freq[i];
        double rev = (double)ang * 0.15915494309189533577; rev -= __builtin_rint(rev);
        const float fr = (float)rev;
        tab[2 * e] = __builtin_amdgcn_cosf(fr); tab[2 * e + 1] = __builtin_amdgcn_sinf(fr); }
}

__device__ __forceinline__ void row_pass(const float* xsrc, float* xdst, const bf16* F, float coef, const float* g_post, const float* g_pre, bf16* XN, int gw, int NGW, int lane) {
    for (int m = gw; m < M; m += NGW) {
        const f32x4* xr = (const f32x4*)(xsrc + (size_t)m * D) + lane;
        f32x4 v[4];
#pragma unroll
        for (int j = 0; j < 4; ++j) v[j] = xr[64 * j];
        if (F) {
            const u32x2* fr = (const u32x2*)(F + (size_t)m * D) + lane; f32x4 f[4]; float ss = 0.f;
#pragma unroll
            for (int j = 0; j < 4; ++j) { const u32x2 w = fr[64 * j]; f[j] = (f32x4){bflo(w.x), bfhi(w.x), bflo(w.y), bfhi(w.y)}; ss += (f[j].x * f[j].x + f[j].y * f[j].y) + (f[j].z * f[j].z + f[j].w * f[j].w); }
            const float rs = coef / sqrtf(wave_sum(ss, lane) * (1.f / D) + 1e-6f);
#pragma unroll
            for (int j = 0; j < 4; ++j) { const f32x4 g = ((const f32x4*)g_post)[lane + 64 * j]; v[j] = v[j] + f[j] * g * rs; }
        }
        u32x2* xo = (u32x2*)((bf16*)xdst + (size_t)m * D) + lane;
#pragma unroll
        for (int j = 0; j < 4; ++j) { u32x2 w; w.x = cvtpk(v[j].x, v[j].y); w.y = cvtpk(v[j].z, v[j].w); xo[64 * j] = w; }
        if (XN) {
            float ss = 0.f;
#pragma unroll
            for (int j = 0; j < 4; ++j) ss += (v[j].x * v[j].x + v[j].y * v[j].y) + (v[j].z * v[j].z + v[j].w * v[j].w);
            const float rs = 1.0f / sqrtf(wave_sum(ss, lane) * (1.f / D) + 1e-6f);
            u32x2* o8 = (u32x2*)(XN + (size_t)m * D) + lane;
#pragma unroll
            for (int j = 0; j < 4; ++j) { const f32x4 g = ((const f32x4*)g_pre)[lane + 64 * j]; const f32x4 y = v[j] * g * rs; u32x2 w; w.x = cvtpk(y.x, y.y); w.y = cvtpk(y.z, y.w); o8[64 * j] = w; }
        }
    }
}

namespace mx {
constexpr int KP = 144, TILEB = 64 * KP;
constexpr int OFF_K = 0, OFF_V = 3 * TILEB, OFF_KM = 6 * TILEB, OFF_PART = OFF_KM + 8 * 64 * 4;
constexpr int OFF_FLAG = OFF_PART + 8 * 8 * 64 * 4;
constexpr int MX_BYTES = OFF_FLAG + 64;
__device__ __forceinline__ int crow(int r, int hi) { return (r & 3) + 8 * (r >> 2) + 4 * hi; }
__device__ __forceinline__ s16x4 vtr(LAS const unsigned char* p) { typedef short v4i16_t __attribute__((ext_vector_type(4))); return __builtin_bit_cast(s16x4, __builtin_amdgcn_ds_read_tr16_b64_v4i16((LAS v4i16_t*)p)); }

__device__ __forceinline__ void tile_load(const bf16* Kg, const bf16* Vg, int row0, int tid, u32x4& kr, u32x4& vr) {
    const int row = tid >> 3, ch = tid & 7;
    kr = *(const u32x4*)(Kg + (size_t)(row0 + row) * NPROJ + ch * 8);
    vr = *(const u32x4*)(Vg + (size_t)(row0 + row) * NPROJ + ch * 8);
}
__device__ __forceinline__ void tile_store(LAS unsigned char* lds, int slot_off, int tid, const u32x4& kr, const u32x4& vr) {
    const int row = tid >> 3, ch = tid & 7;
    *(LAS u32x4*)(lds + OFF_K + slot_off + row * KP + ch * 16) = kr;
    *(LAS u32x4*)(lds + OFF_V + slot_off + row * KP + ch * 16) = vr;
}
__device__ __forceinline__ void qk_tile(LAS const unsigned char* Kb, const bf16x8 (&qr)[4], int r32, int hi, f32x16& p0, f32x16& p1) {
#pragma unroll
    for (int r = 0; r < 16; ++r) { p0[r] = 0.f; p1[r] = 0.f; }
#pragma unroll
    for (int d0 = 0; d0 < 4; ++d0) {
        const bf16x8 k0 = *(LAS const bf16x8*)(Kb + r32 * KP + d0 * 32 + hi * 16);
        const bf16x8 k1 = *(LAS const bf16x8*)(Kb + (32 + r32) * KP + d0 * 32 + hi * 16);
        p0 = MFMA32(k0, qr[d0], p0); p1 = MFMA32(k1, qr[d0], p1);
    }
}
__device__ __forceinline__ void pv_tile(LAS const unsigned char* Vb, int lane, const f32x16& p0, const f32x16& p1, f32x16 (&o)[2]) {
    const int i = lane & 15, q4 = i >> 2, pp = i & 3, g1 = (lane >> 4) & 1, hi = lane >> 5;
    LAS const unsigned char* vb = Vb + (4 * hi + q4) * KP + g1 * 32 + pp * 8;
#pragma unroll
    for (int sub = 0; sub < 2; ++sub)
#pragma unroll
        for (int s = 0; s < 2; ++s) {
            u32x4 pk;
            if (sub == 0) { pk.x = cvtpk(p0[8 * s], p0[8 * s + 1]); pk.y = cvtpk(p0[8 * s + 2], p0[8 * s + 3]); pk.z = cvtpk(p0[8 * s + 4], p0[8 * s + 5]); pk.w = cvtpk(p0[8 * s + 6], p0[8 * s + 7]); }
            else          { pk.x = cvtpk(p1[8 * s], p1[8 * s + 1]); pk.y = cvtpk(p1[8 * s + 2], p1[8 * s + 3]); pk.z = cvtpk(p1[8 * s + 4], p1[8 * s + 5]); pk.w = cvtpk(p1[8 * s + 6], p1[8 * s + 7]); }
            const bf16x8 pb = __builtin_bit_cast(bf16x8, pk);
#pragma unroll
            for (int d0 = 0; d0 < 2; ++d0) {
                const s16x4 lo = vtr(vb + (32 * sub + 16 * s) * KP + d0 * 64);
                const s16x4 hh = vtr(vb + (32 * sub + 16 * s + 8) * KP + d0 * 64);
                const bf16x8 va = {lo[0], lo[1], lo[2], lo[3], hh[0], hh[1], hh[2], hh[3]};
                o[d0] = MFMA32(va, pb, o[d0]);
            }
        }
}
__device__ __forceinline__ void store_ot(bf16* dst  , const f32x16 (&o)[2], int hi, float scale) {
#pragma unroll
    for (int d0 = 0; d0 < 2; ++d0)
#pragma unroll
        for (int g4 = 0; g4 < 4; ++g4) { u32x2 w; w.x = cvtpk(o[d0][4 * g4] * scale, o[d0][4 * g4 + 1] * scale); w.y = cvtpk(o[d0][4 * g4 + 2] * scale, o[d0][4 * g4 + 3] * scale);
            *(u32x2*)(dst + 32 * d0 + 8 * g4 + 4 * hi) = w; }
}

#ifndef MX_NO_SCHED
#define MX_SCHED() do { __builtin_amdgcn_sched_group_barrier(0x100, 8, 0); _Pragma("unroll") for (int i_ = 0; i_ < 8; ++i_) { __builtin_amdgcn_sched_group_barrier(0x008, 1, 0); __builtin_amdgcn_sched_group_barrier(0x002, 20, 0); } } while (0)
#else
#define MX_SCHED() do {} while (0)
#endif
template <bool DIAG> __device__ __forceinline__ void moba_softmax(f32x16& p0, f32x16& p1, int t, int qrel, int hi, int lane, bool mysel, float C, float& mrun, float& lrun, f32x16 (&o)[2]) {
    float bias = 0.f;
    if (DIAG) {
#pragma unroll
        for (int r = 0; r < 16; ++r) { const int kv = 64 * t + crow(r, hi); p0[r] = kv <= qrel ? p0[r] : -INFINITY; p1[r] = kv + 32 <= qrel ? p1[r] : -INFINITY; }
    } else bias = mysel ? 0.f : -INFINITY;
    float rm = fmaxf(p0[0], p1[0]);
#pragma unroll
    for (int r = 1; r < 16; ++r) rm = fmaxf(rm, fmaxf(p0[r], p1[r]));
    rm = fmaxf(rm, shx(rm, 32, lane));
    const float mnew = fmaxf(mrun, rm * C + bias); const float alpha = fexp2(mrun - mnew);
#pragma unroll
    for (int r = 0; r < 16; ++r) { o[0][r] *= alpha; o[1][r] *= alpha; }
    mrun = mnew; const float nb = bias - mnew; float rs = 0.f;
#pragma unroll
    for (int r = 0; r < 16; ++r) { p0[r] = fexp2(__builtin_fmaf(p0[r], C, nb)); p1[r] = fexp2(__builtin_fmaf(p1[r], C, nb)); rs += p0[r] + p1[r]; }
    lrun = lrun * alpha + rs;
}

__device__ __forceinline__ void moba_unit(LAS unsigned char* lds, const bf16* PROJ, bf16* MIX, int b, int h, int j, int tid) {
    const int lane = tid & 63, wid = __builtin_amdgcn_readfirstlane(tid >> 6), r32 = lane & 31, hi = lane >> 5;
    const size_t rowbase = (size_t)b * SEQ; const int q0 = 256 * j;
    const bf16* Kg = PROJ + rowbase * NPROJ + 512 + h * 64; const bf16* Vg = PROJ + rowbase * NPROJ + 1024 + h * 64;
    const bf16* Qp = PROJ + (rowbase + q0 + 32 * wid + r32) * NPROJ + h * 64;
    bf16x8 qr[4];
#pragma unroll
    for (int d0 = 0; d0 < 4; ++d0) qr[d0] = *(const bf16x8*)(Qp + 16 * d0 + 8 * hi);
    u32x4 kr, vr, kr1, vr1; tile_load(Kg, Vg, q0, tid, kr, vr); tile_load(Kg, Vg, q0 + 64, tid, kr1, vr1);
    LAS float* km = (LAS float*)(lds + OFF_KM); LAS float* part = (LAS float*)(lds + OFF_PART);
    { const int ch = tid & 7, rr = tid >> 3;
      for (int n = 0; n < j; ++n) { float a[8];
#pragma unroll
        for (int e = 0; e < 8; ++e) a[e] = 0.f;
#pragma unroll
        for (int i = 0; i < 4; ++i) { const u32x4 v = *(const u32x4*)(Kg + (size_t)(256 * n + rr + 64 * i) * NPROJ + ch * 8);
            a[0] += bflo(v.x); a[1] += bfhi(v.x); a[2] += bflo(v.y); a[3] += bfhi(v.y); a[4] += bflo(v.z); a[5] += bfhi(v.z); a[6] += bflo(v.w); a[7] += bfhi(v.w); }
#pragma unroll
        for (int e = 0; e < 8; ++e) { a[e] += shx(a[e], 8, lane); a[e] += shx(a[e], 16, lane); a[e] += shx(a[e], 32, lane); }
        if (lane < 8) {
#pragma unroll
            for (int e = 0; e < 8; ++e) part[(n * 8 + wid) * 64 + lane * 8 + e] = a[e]; } }
      __syncthreads();
      if (tid < 64) for (int n = 0; n < j; ++n) { float s = 0.f;
#pragma unroll
        for (int w = 0; w < 8; ++w) s += part[(n * 8 + w) * 64 + tid];
        km[n * 64 + tid] = s * (1.0f / 256.0f); }
      tile_store(lds, 0, tid, kr, vr); tile_store(lds, TILEB, tid, kr1, vr1);
      __syncthreads(); }
    float gt[8];
#pragma unroll
    for (int n = 0; n < 8; ++n) { gt[n] = -INFINITY;
        if (n < j) { float s = 0.f;
#pragma unroll
            for (int d0 = 0; d0 < 4; ++d0) { const LAS f32x4* kp = (const LAS f32x4*)(km + n * 64 + 16 * d0 + 8 * hi); const f32x4 k0 = kp[0], k1 = kp[1]; const u32x4 qq = __builtin_bit_cast(u32x4, qr[d0]);
                s += bflo(qq.x) * k0.x + bfhi(qq.x) * k0.y + bflo(qq.y) * k0.z + bfhi(qq.y) * k0.w + bflo(qq.z) * k1.x + bfhi(qq.z) * k1.y + bflo(qq.w) * k1.z + bfhi(qq.w) * k1.w; }
            s += shx(s, 32, lane); gt[n] = s; } }
    unsigned sel = 0u;
#pragma unroll
    for (int n = 0; n < 8; ++n) { int cnt = 0;
#pragma unroll
        for (int n2 = 0; n2 < 8; ++n2) cnt += (gt[n2] > gt[n] || (gt[n2] == gt[n] && n2 < n)) ? 1 : 0;
        if (n < j && cnt < 3) sel |= 1u << n; }
    const float C = 0.125f * 1.4426950408889634f;
    float mrun = -INFINITY, lrun = 0.f; f32x16 o[2];
#pragma unroll
    for (int r = 0; r < 16; ++r) { o[0][r] = 0.f; o[1][r] = 0.f; }
    const int NT = 4 * (j + 1); const int qrel = 32 * wid + r32;
    f32x16 pc0, pc1; qk_tile(lds + OFF_K, qr, r32, hi, pc0, pc1);
    int sc = 0, sn = TILEB, s2 = 2 * TILEB;
    int t = 0;
    for (; t < NT - 1; ++t) {
        if (t + 2 < NT) { const int t2 = t + 2; const int row2 = t2 < 4 ? q0 + 64 * t2 : 256 * ((t2 - 4) >> 2) + 64 * ((t2 - 4) & 3); tile_load(Kg, Vg, row2, tid, kr, vr); }
        f32x16 pn0, pn1;
        if (t < 4) { qk_tile(lds + OFF_K + sn, qr, r32, hi, pn0, pn1); moba_softmax<true>(pc0, pc1, t, qrel, hi, lane, true, C, mrun, lrun, o); pv_tile(lds + OFF_V + sc, lane, pc0, pc1, o); MX_SCHED(); }
        else { const bool mysel = ((sel >> ((t - 4) >> 2)) & 1u) != 0u;
               qk_tile(lds + OFF_K + sn, qr, r32, hi, pn0, pn1); moba_softmax<false>(pc0, pc1, t, qrel, hi, lane, mysel, C, mrun, lrun, o); pv_tile(lds + OFF_V + sc, lane, pc0, pc1, o); MX_SCHED(); }
        if (t + 2 < NT) tile_store(lds, s2, tid, kr, vr);
        __syncthreads();
        pc0 = pn0; pc1 = pn1; { const int tmp = sc; sc = sn; sn = s2; s2 = tmp; }
    }
    if (t < 4) moba_softmax<true>(pc0, pc1, t, qrel, hi, lane, true, C, mrun, lrun, o);
    else moba_softmax<false>(pc0, pc1, t, qrel, hi, lane, ((sel >> ((t - 4) >> 2)) & 1u) != 0u, C, mrun, lrun, o);
    pv_tile(lds + OFF_V + sc, lane, pc0, pc1, o);
    __syncthreads();
    lrun += shx(lrun, 32, lane);
    store_ot(MIX + (rowbase + q0 + 32 * wid + r32) * D + h * 64, o, hi, 1.0f / lrun);
}

__device__ __forceinline__ void sb_sub(f32x16& p, int kvbase, int qpos, int hi, int lane, float& carry, bool needmask) {
    const float LOG2E = 1.4426950408889634f, LN2 = 0.6931471805599453f;
    float L[16]; bool valid[16];
#pragma unroll
    for (int r = 0; r < 16; ++r) { const float z = p[r] * 0.125f; const float e = fexp2(-fabsf(z) * LOG2E); const float sp = fmaxf(z, 0.f) + flog2(1.0f + e) * LN2;
        valid[r] = !needmask || (kvbase + crow(r, hi) < qpos); L[r] = valid[r] ? -sp : 0.f; p[r] = z - sp; }
    float T[4], U[4], X[4];
#pragma unroll
    for (int G = 0; G < 4; ++G) { T[G] = (L[4 * G] + L[4 * G + 1]) + (L[4 * G + 2] + L[4 * G + 3]); U[G] = shx(T[G], 32, lane); X[G] = T[G] + U[G]; }
    float tail[4]; tail[3] = 0.f; tail[2] = X[3]; tail[1] = X[3] + X[2]; tail[0] = X[3] + X[2] + X[1];
#pragma unroll
    for (int G = 0; G < 4; ++G) { const float E = carry + tail[G] + (hi == 0 ? U[G] : 0.f);
        const float e3 = E, e2 = E + L[4 * G + 3], e1 = e2 + L[4 * G + 2], e0 = e1 + L[4 * G + 1];
        p[4 * G + 3] = valid[4 * G + 3] ? fexp2((p[4 * G + 3] + e3) * LOG2E) : 0.f; p[4 * G + 2] = valid[4 * G + 2] ? fexp2((p[4 * G + 2] + e2) * LOG2E) : 0.f;
        p[4 * G + 1] = valid[4 * G + 1] ? fexp2((p[4 * G + 1] + e1) * LOG2E) : 0.f; p[4 * G]     = valid[4 * G]     ? fexp2((p[4 * G]     + e0) * LOG2E) : 0.f; }
    carry += (X[0] + X[1]) + (X[2] + X[3]);
}
__device__ __forceinline__ void sb_unit(LAS unsigned char* lds, const bf16* PROJ, bf16* MIX, int b, int h, int jq, int tid) {
    const int lane = tid & 63, wid = __builtin_amdgcn_readfirstlane(tid >> 6), r32 = lane & 31, hi = lane >> 5;
    const size_t rowbase = (size_t)b * SEQ; const int q0 = 256 * jq;
    const bf16* Kg = PROJ + rowbase * NPROJ + 1536 + h * 64; const bf16* Vg = PROJ + rowbase * NPROJ + 2048 + h * 64;
    const bf16* Qp = PROJ + (rowbase + q0 + 32 * wid + r32) * NPROJ + 1024 + h * 64;
    bf16x8 qr[4];
#pragma unroll
    for (int d0 = 0; d0 < 4; ++d0) qr[d0] = *(const bf16x8*)(Qp + 16 * d0 + 8 * hi);
    const int NT = 4 * jq + 4;
    u32x4 kr, vr, kr1, vr1; tile_load(Kg, Vg, 64 * (NT - 1), tid, kr, vr); tile_load(Kg, Vg, 64 * (NT - 2), tid, kr1, vr1);
    tile_store(lds, 0, tid, kr, vr); tile_store(lds, TILEB, tid, kr1, vr1);
    __syncthreads();
    f32x16 o[2];
#pragma unroll
    for (int r = 0; r < 16; ++r) { o[0][r] = 0.f; o[1][r] = 0.f; }
    float carry = 0.f; const int Q0 = q0 + 32 * wid, qpos = Q0 + r32;
    LAS unsigned* flg = (LAS unsigned*)(lds + OFF_FLAG); bool wdone = false;
    f32x16 pc0, pc1; bool havepc = (64 * (NT - 1) <= Q0 + 30);
    if (havepc) qk_tile(lds + OFF_K, qr, r32, hi, pc0, pc1);
    int sc = 0, sn = TILEB, s2 = 2 * TILEB;
    for (int t = 0; t < NT; ++t) {
        const int kt = NT - 1 - t;
        if (t + 2 < NT) tile_load(Kg, Vg, 64 * (kt - 2), tid, kr, vr);
        const bool cur = havepc && !wdone, nxt = (t + 1 < NT) && (64 * (kt - 1) <= Q0 + 30) && !wdone;
        const bool needmask = (64 * kt + 63 >= Q0);
        f32x16 pn0, pn1;
        if (cur && nxt) {
            qk_tile(lds + OFF_K + sn, qr, r32, hi, pn0, pn1);
            sb_sub(pc1, 64 * kt + 32, qpos, hi, lane, carry, needmask);
            sb_sub(pc0, 64 * kt, qpos, hi, lane, carry, needmask);
            pv_tile(lds + OFF_V + sc, lane, pc0, pc1, o);
            MX_SCHED();
        } else if (cur) {
            sb_sub(pc1, 64 * kt + 32, qpos, hi, lane, carry, needmask);
            sb_sub(pc0, 64 * kt, qpos, hi, lane, carry, needmask);
            pv_tile(lds + OFF_V + sc, lane, pc0, pc1, o);
        } else if (nxt) qk_tile(lds + OFF_K + sn, qr, r32, hi, pn0, pn1);
        if (cur) wdone = (__ballot(carry > -105.0f) == 0ull);
        const int fb = t & 1;
        if (lane == 0) flg[fb * 8 + wid] = wdone ? 1u : 0u;
        if (t + 2 < NT) tile_store(lds, s2, tid, kr, vr);
        __syncthreads();
        const u32x4 f0 = *(const LAS u32x4*)(flg + fb * 8), f1 = *(const LAS u32x4*)(flg + fb * 8 + 4);
        if ((f0.x & f0.y & f0.z & f0.w & f1.x & f1.y & f1.z & f1.w) != 0u) break;
        pc0 = pn0; pc1 = pn1; havepc = nxt; { const int tmp = sc; sc = sn; sn = s2; s2 = tmp; }
    }
    __syncthreads();
    store_ot(MIX + (rowbase + q0 + 32 * wid + r32) * D + 512 + h * 64, o, hi, 1.0f);
}

__device__ __forceinline__ void conv_item(LAS unsigned char* lds, const bf16* PROJ, bf16* MIX, const float* cw, const float* cb, const float* lg, const float* lb, int item, int tid) {
    const int lane = tid & 63, wid = __builtin_amdgcn_readfirstlane(tid >> 6), c = tid;
    const int row0 = 32 * item, pos0 = row0 & (SEQ - 1);
    float w[31];
#pragma unroll
    for (int k = 0; k < 31; ++k) w[k] = cw[k * 512 + c];
    float hw[62];
#pragma unroll
    for (int i = 0; i < 62; ++i) { float hv = 0.f;
        if (pos0 - 30 + i >= 0) { const bf16* rp = PROJ + (size_t)(row0 - 30 + i) * NPROJ; const float a = bf2f(rp[1536 + c]), g = bf2f(rp[2048 + c]); hv = a * sigmoidf_(g); }
        hw[i] = hv; }
    float acc[32]; const float bias = cb[c];
#pragma unroll
    for (int tk = 0; tk < 32; ++tk) { float s = bias;
#pragma unroll
        for (int k = 0; k < 31; ++k) s += w[k] * hw[tk + k];
        acc[tk] = s; }
    LAS float* cbuf = (LAS float*)lds; LAS float* st = (LAS float*)(lds + 32 * 512 * 4);
#pragma unroll
    for (int tk = 0; tk < 32; ++tk) cbuf[tk * 512 + c] = acc[tk];
    __syncthreads();
#pragma unroll
    for (int q = 0; q < 4; ++q) { const int tk = 4 * wid + q; float v[8]; float s = 0.f;
#pragma unroll
        for (int i = 0; i < 8; ++i) { v[i] = cbuf[tk * 512 + lane + 64 * i]; s += v[i]; }
        const float mean = wave_sum(s, lane) * (1.f / 512.f); float s2 = 0.f;
#pragma unroll
        for (int i = 0; i < 8; ++i) { const float d = v[i] - mean; s2 += d * d; }
        const float rstd = 1.0f / sqrtf(wave_sum(s2, lane) * (1.f / 512.f) + 1e-5f);
        if (lane == 0) { st[2 * tk] = mean; st[2 * tk + 1] = rstd; } }
    __syncthreads();
    const float g = lg[c], bb = lb[c];
#pragma unroll
    for (int tk = 0; tk < 32; ++tk) { const float y = (acc[tk] - st[2 * tk]) * st[2 * tk + 1] * g + bb; const float ov = siluf_(y);
        MIX[(size_t)(row0 + tk) * D + 512 + c] = (bf16)(cvtpk(ov, 0.f) & 0xffffu); }
    __syncthreads();
}

constexpr int SGP = 272;
__device__ __forceinline__ void sgu_item(LAS unsigned char* lds, const bf16* PROJ, bf16* MIX, const float* lg, const float* lb, const float* ws_, const float* bs_, int item, int tid) {
    const int lane = tid & 63, wid = __builtin_amdgcn_readfirstlane(tid >> 6), r32 = lane & 31, hi = lane >> 5;
    const size_t row0 = (size_t)item * 128;
    LAS float* st = (LAS float*)lds;
    LAS unsigned char* vnT = lds + 1024;
    for (int q0 = 0; q0 < 16; q0 += 4) { u32x4 vv[4];
#pragma unroll
        for (int i = 0; i < 4; ++i) vv[i] = *(const u32x4*)(PROJ + (row0 + 16 * wid + q0 + i) * NPROJ + 512 + lane * 8);
        float x[4][8], sm[4];
#pragma unroll
        for (int i = 0; i < 4; ++i) { const u32x4 v = vv[i]; x[i][0] = bflo(v.x); x[i][1] = bfhi(v.x); x[i][2] = bflo(v.y); x[i][3] = bfhi(v.y); x[i][4] = bflo(v.z); x[i][5] = bfhi(v.z); x[i][6] = bflo(v.w); x[i][7] = bfhi(v.w); sm[i] = 0.f;
#pragma unroll
            for (int e = 0; e < 8; ++e) { x[i][e] = geluf_(x[i][e]); sm[i] += x[i][e]; } }
#pragma unroll
        for (int o = 1; o < 64; o <<= 1) {
#pragma unroll
            for (int i = 0; i < 4; ++i) sm[i] += shx(sm[i], o, lane); }
        float s2[4];
#pragma unroll
        for (int i = 0; i < 4; ++i) { const float mean = sm[i] * (1.f / 512.f); sm[i] = mean; s2[i] = 0.f;
#pragma unroll
            for (int e = 0; e < 8; ++e) { const float d = x[i][e] - mean; s2[i] += d * d; } }
#pragma unroll
        for (int o = 1; o < 64; o <<= 1) {
#pragma unroll
            for (int i = 0; i < 4; ++i) s2[i] += shx(s2[i], o, lane); }
        if (lane == 0) {
#pragma unroll
            for (int i = 0; i < 4; ++i) { const int s = 16 * wid + q0 + i; st[2 * s] = sm[i]; st[2 * s + 1] = 1.0f / sqrtf(s2[i] * (1.f / 512.f) + 1e-5f); } } }
    __syncthreads();
    const int wt = wid & 3, wcg = wid >> 2;
    for (int g = 0; g < 4; ++g) {
        { const int s = tid & 127, cs = tid >> 7; const float mean = st[2 * s], rstd = st[2 * s + 1];
          const bf16* vp = PROJ + (row0 + s) * NPROJ + 512 + 128 * g + 32 * cs;
#pragma unroll
          for (int q = 0; q < 4; ++q) { const u32x4 v = *(const u32x4*)(vp + 8 * q);
              float x[8] = {bflo(v.x), bfhi(v.x), bflo(v.y), bfhi(v.y), bflo(v.z), bfhi(v.z), bflo(v.w), bfhi(v.w)};
#pragma unroll
              for (int e = 0; e < 8; ++e) { const int cl = 32 * cs + 8 * q + e; const int cgl = 128 * g + cl; const float y = (geluf_(x[e]) - mean) * rstd * lg[cgl] + lb[cgl];
                  *(LAS unsigned short*)(vnT + cl * SGP + 2 * s) = (unsigned short)(cvtpk(y, 0.f) & 0xffffu); } } }
        __syncthreads();
        f32x16 acc[2];
#pragma unroll
        for (int r = 0; r < 16; ++r) { acc[0][r] = 0.f; acc[1][r] = 0.f; }
        const int trow = 32 * wt + r32; const float* wrow = ws_ + ((size_t)g * 128 + trow) * 128;
        for (int ks = 0; ks < 2 * (wt + 1); ++ks) { const int s0 = 16 * ks + 8 * hi;
            const f32x4 w0 = *(const f32x4*)(wrow + s0), w1 = *(const f32x4*)(wrow + s0 + 4);
            u32x4 pk; pk.x = cvtpk(s0 + 0 <= trow ? w0.x : 0.f, s0 + 1 <= trow ? w0.y : 0.f); pk.y = cvtpk(s0 + 2 <= trow ? w0.z : 0.f, s0 + 3 <= trow ? w0.w : 0.f);
            pk.z = cvtpk(s0 + 4 <= trow ? w1.x : 0.f, s0 + 5 <= trow ? w1.y : 0.f); pk.w = cvtpk(s0 + 6 <= trow ? w1.z : 0.f, s0 + 7 <= trow ? w1.w : 0.f);
            const bf16x8 wa = __builtin_bit_cast(bf16x8, pk);
#pragma unroll
            for (int ct = 0; ct < 2; ++ct) { const bf16x8 vb = *(LAS const bf16x8*)(vnT + (64 * wcg + 32 * ct + r32) * SGP + s0 * 2); acc[ct] = MFMA32(vb, wa, acc[ct]); } }
        { const int t = 32 * wt + r32; const float bias = bs_[g * 128 + t]; const bf16* up = PROJ + (row0 + t) * NPROJ + 128 * g + 64 * wcg + 4 * hi; bf16* op = MIX + (row0 + t) * D + 128 * g + 64 * wcg + 4 * hi;
#pragma unroll
          for (int ct = 0; ct < 2; ++ct)
#pragma unroll
            for (int g4 = 0; g4 < 4; ++g4) { const u32x2 uw = *(const u32x2*)(up + 32 * ct + 8 * g4);
                const float o0 = geluf_(bflo(uw.x)) * (acc[ct][4 * g4] + bias), o1 = geluf_(bfhi(uw.x)) * (acc[ct][4 * g4 + 1] + bias), o2 = geluf_(bflo(uw.y)) * (acc[ct][4 * g4 + 2] + bias), o3 = geluf_(bfhi(uw.y)) * (acc[ct][4 * g4 + 3] + bias);
                u32x2 w; w.x = cvtpk(o0, o1); w.y = cvtpk(o2, o3); *(u32x2*)(op + 32 * ct + 8 * g4) = w; } }
        __syncthreads();
    }
}
}


#define RLX_AGENT __ATOMIC_RELAXED, __HIP_MEMORY_SCOPE_AGENT
#define XB_TMO      128
#define XB_XCNT(j)  (256  + 64 * (j))
#define XB_XSUB(j)  (1280 + 64 * (j))
#define XB_XGEN(j)  (2304 + 64 * (j))
#define XB_TOP      3328
#define XB_TOPGEN   3392
#define XCD_BAR_WORDS 3456
#define XB_SPIN_CAP (1u << 18)

__device__ __forceinline__ unsigned xb_ld(unsigned* p)              { return __hip_atomic_load(p, __ATOMIC_RELAXED, __HIP_MEMORY_SCOPE_AGENT); }
__device__ __forceinline__ unsigned xb_add(unsigned* p, unsigned v) { return __hip_atomic_fetch_add(p, v, __ATOMIC_RELAXED, __HIP_MEMORY_SCOPE_AGENT); }
__device__ __forceinline__ unsigned xb_xcc_id() { return (unsigned)__builtin_amdgcn_s_getreg((3 << 11) | 20) & 0xFu; }
#define XB_SPIN(cond, bar) do { unsigned _sp = 0; while (cond) { __builtin_amdgcn_s_sleep(1); \
    if ((++_sp & 255u) == 0u) { if (xb_ld(&(bar)[XB_TMO])) break; if (_sp > XB_SPIN_CAP) { atomicAdd(&(bar)[XB_TMO], 1u); break; } } } } while (0)

struct XcdBarrier {
    unsigned* bar; unsigned x;
    volatile LAS unsigned* st;
};

__device__ __forceinline__ XcdBarrier xcd_barrier_post(unsigned* bar, volatile LAS unsigned* st) {
    XcdBarrier b; b.bar = bar; b.x = xb_xcc_id(); b.st = st;
    if (threadIdx.x == 0) (void)xb_add(&bar[XB_XCNT(b.x)], 1u);
    return b;
}
__device__ __forceinline__ void xcd_barrier_complete(unsigned* bar, unsigned x, unsigned& nloc, unsigned& nx) {
    const unsigned G = gridDim.x * gridDim.y * gridDim.z;
    unsigned sum, cnt, mine, sp = 0u;
    for (;;) {
        sum = 0u; cnt = 0u; mine = 0u;
#pragma unroll
        for (unsigned j = 0; j < 16; ++j) { const unsigned c = xb_ld(&bar[XB_XCNT(j)]); sum += c; cnt += (c > 0u) ? 1u : 0u; mine = (j == x) ? c : mine; }
        if (sum == G) break;
        __builtin_amdgcn_s_sleep(1);
        if ((++sp & 255u) == 0u) { if (xb_ld(&bar[XB_TMO])) break; if (sp > XB_SPIN_CAP) { atomicAdd(&bar[XB_TMO], 1u); break; } }
    }
    nloc = mine > 0u ? mine : 1u; nx = cnt > 0u ? cnt : 1u;
}

__device__ __forceinline__ void xcd_barrier(const XcdBarrier& b) {
    asm volatile("s_waitcnt vmcnt(0)" ::: "memory");
    __syncthreads();
    if (threadIdx.x == 0) {
        unsigned* bar = b.bar;
        __builtin_amdgcn_s_waitcnt(0);
        unsigned nloc = b.st[0], nx = b.st[1];
        if (nloc == 0u) { xcd_barrier_complete(bar, b.x, nloc, nx); b.st[0] = nloc; b.st[1] = nx; }
        const unsigned old = xb_add(&bar[XB_XSUB(b.x)], 1u);
        const unsigned gen = old / nloc;
        if (old + 1u == (gen + 1u) * nloc) {
            __builtin_amdgcn_fence(__ATOMIC_RELEASE, "agent");
            asm volatile("s_waitcnt vmcnt(0)" ::: "memory");
            const unsigned og = xb_add(&bar[XB_TOP], 1u);
            const unsigned tg = og / nx;
            if (og + 1u == (tg + 1u) * nx) xb_add(&bar[XB_TOPGEN], 1u);
            else XB_SPIN(xb_ld(&bar[XB_TOPGEN]) == tg, bar);
            __builtin_amdgcn_fence(__ATOMIC_ACQUIRE, "agent");
            xb_add(&bar[XB_XGEN(b.x)], 1u);
            asm volatile("s_waitcnt vmcnt(0)" ::: "memory");
        } else {
            XB_SPIN(xb_ld(&bar[XB_XGEN(b.x)]) == gen, bar);
            __builtin_amdgcn_fence(__ATOMIC_ACQUIRE, "agent");
            asm volatile("s_waitcnt vmcnt(0)" ::: "memory");
        }
    }
    __syncthreads();
}

#ifndef PROBE_SYNC
#define PROBE_SYNC 0
#endif
#ifndef PROBE_REP_PRO
#define PROBE_REP_PRO 1
#endif
#ifndef PROBE_REP_G1
#define PROBE_REP_G1 1
#endif
#ifndef PROBE_REP_G2
#define PROBE_REP_G2 1
#endif
#ifndef PROBE_REP_G3
#define PROBE_REP_G3 1
#endif
#ifndef PROBE_REP_G4
#define PROBE_REP_G4 1
#endif
#ifndef PROBE_REP_MIXE
#define PROBE_REP_MIXE 1
#endif
#ifndef PROBE_REP_MIXO
#define PROBE_REP_MIXO 1
#endif
__global__ void __launch_bounds__(NTHREADS, 2) fwd_megakernel(Params p_) {
    extern __shared__ __attribute__((aligned(16))) unsigned char lds_raw[];
    const int ph_lo = p_.ph_lo, ph_hi = p_.ph_hi;
    if (threadIdx.x < 2) ((LAS unsigned*)((LAS unsigned char*)lds_raw + LDS_MISC))[threadIdx.x] = 0u;
    __syncthreads();
    (void)xcd_barrier_post((unsigned*)(p_.ws + WS_CTL), (volatile LAS unsigned*)((LAS unsigned char*)lds_raw + LDS_MISC));
    int rr = 0, nsync = 0;
    for (int ph = ph_lo; ph < ph_hi;) {
        if (ph > ph_lo || rr > 0) {
            if (ph_hi < 0) cg::this_grid().sync();
            { XcdBarrier b; b.bar = (unsigned*)(p_.ws + WS_CTL); b.x = xb_xcc_id(); b.st = (volatile LAS unsigned*)((LAS unsigned char*)lds_raw + LDS_MISC); xcd_barrier(b); }
            ++nsync;
        }
#if PROBE_SYNC
        { XcdBarrier b; b.bar = (unsigned*)(p_.ws + WS_CTL); b.x = xb_xcc_id(); b.st = (volatile LAS unsigned*)((LAS unsigned char*)lds_raw + LDS_MISC); xcd_barrier(b); }
#endif
        int zero; asm volatile("s_mov_b32 %0, 0" : "=s"(zero));
        PP p = (PP)((const __attribute__((address_space(4))) char*)__builtin_amdgcn_kernarg_segment_ptr() + zero);
        LAS unsigned char* lds = (LAS unsigned char*)lds_raw;
        int tid_; asm volatile("v_mov_b32 %0, %1" : "=v"(tid_) : "v"((int)threadIdx.x));
        const int tid = tid_, lane = tid & 63, wave = __builtin_amdgcn_readfirstlane(tid >> 6);
        const int G = gridDim.x, bx = blockIdx.x + zero;
        const int gw = bx * NWAVES + wave, NGW = G * NWAVES;
        unsigned char* ws = p->ws;
        bf16* XN = (bf16*)(ws + WS_XN); bf16* HB = (bf16*)(ws + WS_HB); bf16* PROJ = (bf16*)(ws + WS_PROJ); bf16* FB = (bf16*)(ws + WS_F); bf16* MIX = (bf16*)(ws + WS_MIX);
        if (ph == 0) {
            prologue_weights(p, lds, gw, NGW, wave, lane);
            prologue_rope(p, bx * NTHREADS + tid, G * NTHREADS);
            row_pass(p->x, (float*)FB, nullptr, 0.f, nullptr, p->norm_g, XN, gw, NGW, lane);
            __syncthreads();
            if (++rr >= PROBE_REP_PRO) { rr = 0; ++ph; }
            continue;
        }
        const int L = (ph - 1) / 7, s = (ph - 1) % 7;
        const unsigned char* wl = ws + WS_W + (size_t)L * WL_BYTES;
        const bool even = (L & 1) == 0; const int li = L >> 1;
        if (s == 3) {
            unsigned* qctr = (unsigned*)(ws + WS_CTL + CTL_Q) + 64 * L;
            volatile LAS unsigned* qslot = (volatile LAS unsigned*)(lds + LDS_MISC + 16);
            const int total = even ? 1024 : 640;
            for (;;) {
                if (tid == 0) *qslot = __hip_atomic_fetch_add(qctr, 1u, __ATOMIC_RELAXED, __HIP_MEMORY_SCOPE_AGENT);
                __syncthreads();
                const int idx = __builtin_amdgcn_readfirstlane((int)*qslot);
                __syncthreads();
                if (idx >= total) break;
                int tq_; asm volatile("v_mov_b32 %0, %1" : "=v"(tq_) : "v"(tid));
                const int tq = tq_;
                if (even) {
                    if (idx < 512) { const int j = 7 - (idx >> 6), bh = idx & 63; mx::moba_unit(lds, PROJ, MIX, bh >> 3, bh & 7, j, tq); }
                    else mx::conv_item(lds, PROJ, MIX, p->conv_w + (size_t)li * 31 * 512, p->conv_b + li * 512, p->conv_ln_g + li * 512, p->conv_ln_b + li * 512, idx - 512, tq);
                } else {
                    if (idx < 128) mx::sgu_item(lds, PROJ, MIX, p->sgu_ln_g + li * 512, p->sgu_ln_b + li * 512, p->sgu_w + (size_t)li * 4 * 128 * 128, p->sgu_b + li * 4 * 128, idx, tq);
                    else { const int u = idx - 128, jq = 7 - (u >> 6), bh = u & 63; mx::sb_unit(lds, PROJ, MIX, bh >> 3, bh & 7, jq, tq); }
                }
            }
        } else {
            const bf16* A; size_t wo; int N, K; bf16* O = nullptr; int ldc = 0, rc = 0, sw = 0, fm = 0;
            const float* ng = p->norm_g + (size_t)L * 6 * D;
            pg8::FusedNorm fn{}; fn.xb = FB; fn.fout = nullptr; fn.slots1 = (float*)(ws + WS_SLOT1); fn.slots2 = (float*)(ws + WS_SLOT2);
            fn.cnt1 = (unsigned*)(ws + WS_CTL + CTL_CNT1); fn.cnt2 = (unsigned*)(ws + WS_CTL + CTL_CNT2);
            if (s == 0 || s == 5) { A = XN; wo = (s == 0 ? WL_GU0 : WL_GU1); N = 2 * FF; K = D; O = HB; ldc = FF; sw = 1; }
            else if (s == 1 || s == 6) { A = HB; wo = (s == 1 ? WL_D0 : WL_D1); N = D; K = FF; fm = 1; fn.coef = 0.5f; fn.g_post = ng + (s == 1 ? 1 : 5) * D; fn.g_pre = ng + (s == 1 ? 2 : 6) * D;
                fn.xn = XN; fn.fout = (s == 6 && L == DEPTH - 1) ? p->out : nullptr; fn.target = 32u * (unsigned)(3 * L + (s == 1 ? 1 : 3)); }
            else if (s == 2) { A = XN; wo = WL_IN; N = NPROJ; K = D; O = PROJ; ldc = NPROJ; rc = even ? 1024 : 0; }
            else { A = MIX; wo = WL_OUT; N = D; K = D; fm = 1; fn.coef = 1.0f; fn.g_post = ng + 3 * D; fn.g_pre = ng + 4 * D; fn.xn = XN; fn.target = 32u * (unsigned)(3 * L + 2); }
            pg8::Gemm g{A, (const bf16*)(wl + wo), M, N, K}; pg8::StaticOrder S; S.init(M, N, G, bx);
            pg8::EpiUni E{O, ldc, (const float*)(ws + WS_ROPE), rc, sw, fm, fn};
            pg8::gemm_phase<pg8::EpiUni, pg8::StaticOrder, true, true>(lds, g, S, E, tid);
            if ((s == 0 || s == 2 || s == 5) && bx >= 128 && G == 256) {
                int tq_; asm volatile("v_mov_b32 %0, %1" : "=v"(tq_) : "v"(tid));
                const int lq = tq_ & 63, wq = __builtin_amdgcn_readfirstlane(tq_ >> 6);
                int ra, na, Lb = L, rb, nb;
                if (s == 0) { ra = 5632; na = 176; rb = 8448; nb = 160; }
                else if (s == 2) { ra = 9728; na = 64; rb = 2816; nb = 352; }
                else { ra = 7040; na = 176; Lb = L + 1; rb = 0; nb = (L < DEPTH - 1) ? 352 : 0; }
                for (int w = bx - 128; w < na + nb; w += 128) { const bool first = w < na;
                    convert_wave_item(p, first ? L : Lb, (first ? ra + w * 8 : rb + (w - na) * 8) + wq, (LAS float*)(lds + wq * 16384), lq); }
                __syncthreads();
            }
        }
        { const int reps = (s == 0 || s == 5) ? PROBE_REP_G1 : s == 2 ? PROBE_REP_G3 : 1;
          if (++rr >= reps) { rr = 0; ++ph; } }
    }
}
constexpr int N_PHASES = 1 + 7 * DEPTH;

#ifndef MK_PER_PHASE
#define MK_PER_PHASE 0
#endif
extern "C" void kernel_launch(void* const* d_in, const int* in_sizes, int n_in, void* d_out, int out_size, void* d_ws, size_t ws_size, hipStream_t stream) {
    static int grid = 0;
    if (grid == 0) {
        if (n_in != 17 || out_size != M * D || ws_size < WS_END) { fprintf(stderr, "kernel_launch: unexpected shapes (n_in %d out %d ws %zu)\n", n_in, out_size, ws_size); grid = -1; return; }
        int dev = 0, cus = 0, per_cu = 0;
        hipGetDevice(&dev); hipDeviceGetAttribute(&cus, hipDeviceAttributeMultiprocessorCount, dev);
        if (hipFuncSetAttribute((const void*)fwd_megakernel, hipFuncAttributeMaxDynamicSharedMemorySize, LDS_BYTES) != hipSuccess) { fprintf(stderr, "kernel_launch: hipFuncSetAttribute failed\n"); grid = -1; return; }
        if (hipOccupancyMaxActiveBlocksPerMultiprocessor(&per_cu, (const void*)fwd_megakernel, NTHREADS, LDS_BYTES) != hipSuccess || per_cu < 1) { fprintf(stderr, "kernel_launch: occupancy query says %d\n", per_cu); per_cu = 1; }
        (void)hipGetLastError();
        grid = cus * 1;
    }
    if (grid < 0) return;
    if (hipMemsetAsync((unsigned char*)d_ws + WS_CTL, 0, CTL_BYTES, stream) != hipSuccess) { fprintf(stderr, "kernel_launch: memset of the barrier words failed\n"); return; }
    Params p{};
    p.x = (const float*)d_in[0]; p.norm_g = (const float*)d_in[1]; p.w_gate = (const float*)d_in[2]; p.w_up = (const float*)d_in[3]; p.w_down = (const float*)d_in[4];
    p.ab_w_in = (const float*)d_in[5]; p.ab_w_out = (const float*)d_in[6]; p.conv_w = (const float*)d_in[7]; p.conv_b = (const float*)d_in[8]; p.conv_ln_g = (const float*)d_in[9]; p.conv_ln_b = (const float*)d_in[10];
    p.cd_w_in = (const float*)d_in[11]; p.cd_w_out = (const float*)d_in[12]; p.sgu_ln_g = (const float*)d_in[13]; p.sgu_ln_b = (const float*)d_in[14]; p.sgu_w = (const float*)d_in[15]; p.sgu_b = (const float*)d_in[16];
    p.out = (float*)d_out; p.ws = (unsigned char*)d_ws;
    for (int i = 0; i < 32; ++i) p.inv_freq[i] = powf(10000.0f, -(float)(2 * i) / 64.0f);
#if MK_PER_PHASE
    for (int ph = 0; ph < N_PHASES; ++ph) { p.ph_lo = ph; p.ph_hi = ph + 1; hipLaunchKernelGGL(fwd_megakernel, dim3(grid), dim3(NTHREADS), LDS_BYTES, stream, p); }
#else
    p.ph_lo = 0; p.ph_hi = N_PHASES;
    void* args[] = {&p};
    hipError_t e = hipLaunchCooperativeKernel((const void*)fwd_megakernel, dim3(grid), dim3(NTHREADS), args, LDS_BYTES, stream);
    if (e != hipSuccess) fprintf(stderr, "cooperative launch failed: %s (grid %d)\n", hipGetErrorString(e), grid);
#endif
}
```

```cpp
#include <hip/hip_runtime.h>
#include <hip/hip_cooperative_groups.h>
#include <cstdio>
#include <cstdint>
#include <cmath>
namespace cg = cooperative_groups;

#define LAS __attribute__((address_space(3)))
typedef float f32x2_t __attribute__((ext_vector_type(2)));
typedef __bf16 bf16x2_t __attribute__((ext_vector_type(2)));
__device__ __forceinline__ unsigned cvtpk(float lo, float hi) { f32x2_t v = {lo, hi}; bf16x2_t b = __builtin_convertvector(v, bf16x2_t); return __builtin_bit_cast(unsigned, b); }
__device__ __forceinline__ float bflo(unsigned u) { return __uint_as_float(u << 16); }
__device__ __forceinline__ float bfhi(unsigned u) { return __uint_as_float(u & 0xffff0000u); }
__device__ __forceinline__ float bf2f(unsigned short b) { return __uint_as_float((unsigned)b << 16); }
__device__ __forceinline__ float fexp2(float x) { return __builtin_amdgcn_exp2f(x); }
__device__ __forceinline__ float flog2(float x) { return __builtin_amdgcn_logf(x); }
__device__ __forceinline__ float frcp(float x) { return __builtin_amdgcn_rcpf(x); }
__device__ __forceinline__ float sigmoidf_(float x) { return frcp(1.0f + fexp2(-1.4426950408889634f * x)); }
__device__ __forceinline__ float siluf_(float x) { return x * sigmoidf_(x); }
__device__ __forceinline__ float geluf_(float x) { const float y = 0.7978845608028654f * (x + 0.044715f * x * x * x); return x * sigmoidf_(2.0f * y); }

__device__ __forceinline__ float shx(float v, int o, int lane) { return __builtin_bit_cast(float, __builtin_amdgcn_ds_bpermute((lane ^ o) << 2, __builtin_bit_cast(int, v))); }
namespace pg8 {
#define PG8_LAS __attribute__((address_space(3)))
typedef unsigned short bf16_t;
typedef short bf16x8 __attribute__((ext_vector_type(8)));
typedef float f32x4 __attribute__((ext_vector_type(4)));
typedef unsigned u32x4 __attribute__((ext_vector_type(4)));
constexpr int BM = 256, BK = 64, HALF = 128, HTB = HALF * BK * 2  , STAGE_BYTES = 8 * HTB, NXCD = 8, WGM = 8;

__host__ __device__ __forceinline__ int lds_byte(int r, int c) { const int st = (r >> 4) * 2 + (c >> 5), rr = r & 15, cc = c & 31, ob = rr * 64 + cc * 2; return st * 1024 + (ob ^ (((ob >> 9) & 1) << 5)); }
__host__ __device__ __forceinline__ void stage_rc(int b, int& R, int& C) { const int st = b / 1024, sb = b % 1024, swz = sb ^ (((sb >> 9) & 1) << 5); R = (st >> 1) * 16 + swz / 64; C = (st & 1) * 32 + (swz % 64) / 2; }
__host__ __device__ __forceinline__ int perm32(int rho) { const int n = rho >> 4, i = rho & 15; return 8 * (i >> 2) + 4 * n + (i & 3); }

struct Unit { int pm, pn; };
struct Gemm { const bf16_t* A; const bf16_t* Bt; int M, N, K; };

struct StaticOrder {
    int nM, nN, nwg, G, c;
    __host__ __device__ void init(int M, int N, int G_, int c_) { nM = M / BM; nN = N / BM; nwg = nM * nN; G = G_; c = c_; }
    __host__ __device__ bool next(int i, Unit& u) const {
        const long L = (long)i * G + c; if (L >= nwg) return false;
        int wgid = (int)L; { const int q = nwg / NXCD, r = nwg % NXCD, xcd = wgid % NXCD, off = wgid / NXCD; wgid = (xcd < r ? xcd * (q + 1) : r * (q + 1) + (xcd - r) * q) + off; }
        const int nig = WGM * nN, gid = wgid / nig, fm = gid * WGM, gsz = (nM - fm) < WGM ? (nM - fm) : WGM;
        u.pm = fm + ((wgid % nig) % gsz); u.pn = (wgid % nig) / gsz; return true;
    }
    __device__ __forceinline__ void a_ready(const Unit&) const {}
    __device__ __forceinline__ void done(const Unit&) const {}
};

__device__ __forceinline__ float silu_(float x) { return x * __builtin_amdgcn_rcpf(1.0f + __builtin_amdgcn_exp2f(-1.4426950408889634f * x)); }
struct EpiSwiGLU {
    static constexpr bool PERM = true, AFTER_DRAIN = false;
    bf16_t* O; int ldc;
    __device__ __forceinline__ void operator()(const f32x4 (&acc)[2][2][4][2], const Unit& u, int wr, int wc, int fr, int fq) const {
        const int row0 = u.pm * BM + wr * 64 + fr, col0 = u.pn * HALF + wc * 32 + 8 * fq;
#pragma unroll
        for (int ai = 0; ai < 2; ++ai)
#pragma unroll
            for (int m = 0; m < 4; ++m) { bf16_t* rowp = O + (size_t)(row0 + ai * HALF + m * 16) * ldc + col0;
                const f32x4 g0 = acc[ai][0][m][0], g1 = acc[ai][0][m][1], u0 = acc[ai][1][m][0], u1 = acc[ai][1][m][1];
                u32x4 w; w.x = cvtpk(silu_(g0[0]) * u0[0], silu_(g0[1]) * u0[1]); w.y = cvtpk(silu_(g0[2]) * u0[2], silu_(g0[3]) * u0[3]);
                w.z = cvtpk(silu_(g1[0]) * u1[0], silu_(g1[1]) * u1[1]); w.w = cvtpk(silu_(g1[2]) * u1[2], silu_(g1[3]) * u1[3]);
                *(u32x4*)rowp = w; asm volatile("" ::: "memory"); }
    }
};
template <bool ROPE> struct EpiBf16 {
    static constexpr bool PERM = true, AFTER_DRAIN = false;
    bf16_t* O; int ldc; const float* rope; int rope_cols;
    __device__ __forceinline__ void operator()(const f32x4 (&acc)[2][2][4][2], const Unit& u, int wr, int wc, int fr, int fq) const {
        const int row0 = u.pm * BM + wr * 64 + fr, col0 = u.pn * BM + wc * 32 + 8 * fq;
        const bool dorope = ROPE && (u.pn * BM < rope_cols);
#pragma unroll
        for (int ai = 0; ai < 2; ++ai) {
            f32x4 rc0[4], rc1[4];
#pragma unroll
            for (int m = 0; m < 4; ++m) { rc0[m] = (f32x4){1.f, 0.f, 1.f, 0.f}; rc1[m] = (f32x4){1.f, 0.f, 1.f, 0.f};
                if (ROPE) { if (dorope) { const int row = row0 + ai * HALF + m * 16; const f32x4* rp = (const f32x4*)(rope + ((size_t)(row & 2047) * 32 + 16 * (wc & 1) + 4 * fq) * 2); rc0[m] = rp[0]; rc1[m] = rp[1]; } } }
#pragma unroll
            for (int m = 0; m < 4; ++m) { const int row = row0 + ai * HALF + m * 16; bf16_t* rowp = O + (size_t)row * ldc + col0;
                const f32x4 c0 = rc0[m], c1 = rc1[m];
#pragma unroll
                for (int bj = 0; bj < 2; ++bj) { f32x4 v0 = acc[ai][bj][m][0], v1 = acc[ai][bj][m][1];
                    if (ROPE) { const f32x4 a = v0, b = v1;
                        v0[0] = a[0] * c0[0] - a[1] * c0[1]; v0[1] = a[1] * c0[0] + a[0] * c0[1]; v0[2] = a[2] * c0[2] - a[3] * c0[3]; v0[3] = a[3] * c0[2] + a[2] * c0[3];
                        v1[0] = b[0] * c1[0] - b[1] * c1[1]; v1[1] = b[1] * c1[0] + b[0] * c1[1]; v1[2] = b[2] * c1[2] - b[3] * c1[3]; v1[3] = b[3] * c1[2] + b[2] * c1[3]; }
                    u32x4 w; w.x = cvtpk(v0[0], v0[1]); w.y = cvtpk(v0[2], v0[3]); w.z = cvtpk(v1[0], v1[1]); w.w = cvtpk(v1[2], v1[3]);
                    *(u32x4*)(rowp + bj * HALF) = w; }
                asm volatile("" ::: "memory"); } }
    }
};


__device__ __forceinline__ void panel_ss_publish(const f32x4 (&v)[2][2][4][2], const Unit& u, int wr, int wc, int fr, int fq, PG8_LAS unsigned char* lds, int wid, int lane, float* slots, unsigned* cnt) {
    PG8_LAS float* P = (PG8_LAS float*)lds;
#pragma unroll
    for (int ai = 0; ai < 2; ++ai)
#pragma unroll
        for (int m = 0; m < 4; ++m) { float s = 0.f;
#pragma unroll
            for (int bj = 0; bj < 2; ++bj)
#pragma unroll
                for (int n = 0; n < 2; ++n) { const f32x4 x = v[ai][bj][m][n]; s += (x[0] * x[0] + x[1] * x[1]) + (x[2] * x[2] + x[3] * x[3]); }
            s += shx(s, 16, lane); s += shx(s, 32, lane);
            if (fq == 0) P[(ai * HALF + wr * 64 + m * 16 + fr) * 4 + wc] = s; }
    asm volatile("s_waitcnt lgkmcnt(0)" ::: "memory"); __builtin_amdgcn_s_barrier(); asm volatile("" ::: "memory");
    const int row = wid * 32 + (lane & 31);
    if (lane < 32) { const f32x4 a = *(const PG8_LAS f32x4*)(P + row * 4); const float t = (a[0] + a[1]) + (a[2] + a[3]);
        __hip_atomic_store(slots + (size_t)(u.pm * BM + row) * 4 + u.pn, t, __ATOMIC_RELAXED, __HIP_MEMORY_SCOPE_AGENT); }
    asm volatile("s_waitcnt vmcnt(0)" ::: "memory");
    if (lane == 0) __hip_atomic_fetch_add(cnt + 64 * u.pm, 1u, __ATOMIC_RELAXED, __HIP_MEMORY_SCOPE_AGENT);
}
__device__ __forceinline__ void panel_ss_collect(const Unit& u, PG8_LAS unsigned char* lds, int wid, int lane, float* slots, unsigned* cnt, unsigned target) {
    PG8_LAS float* S = (PG8_LAS float*)(lds + 4096);
    const int row = wid * 32 + (lane & 31);
    if (wid == 0) { unsigned sp = 0;
        while ((unsigned)__builtin_amdgcn_readfirstlane(__hip_atomic_load(cnt + 64 * u.pm, __ATOMIC_RELAXED, __HIP_MEMORY_SCOPE_AGENT)) < target) { __builtin_amdgcn_s_sleep(2); if (++sp > (1u << 22)) break; }
        __builtin_amdgcn_fence(__ATOMIC_ACQUIRE, "agent"); }
    asm volatile("s_waitcnt vmcnt(0) lgkmcnt(0)" ::: "memory"); __builtin_amdgcn_s_barrier(); asm volatile("" ::: "memory");
    if (lane < 32) { const float* sl = slots + (size_t)(u.pm * BM + row) * 4; float t = 0.f;
#pragma unroll
        for (int q = 0; q < 4; ++q) t += __hip_atomic_load(sl + q, __ATOMIC_RELAXED, __HIP_MEMORY_SCOPE_AGENT);
        S[row] = t; }
    asm volatile("s_waitcnt lgkmcnt(0)" ::: "memory"); __builtin_amdgcn_s_barrier(); asm volatile("" ::: "memory");
}
__device__ __forceinline__ void panel_ss(const f32x4 (&v)[2][2][4][2], const Unit& u, int wr, int wc, int fr, int fq, PG8_LAS unsigned char* lds, int wid, int lane, float* slots, unsigned* cnt, unsigned target) {
    panel_ss_publish(v, u, wr, wc, fr, fq, lds, wid, lane, slots, cnt); panel_ss_collect(u, lds, wid, lane, slots, cnt, target);
}
__device__ __forceinline__ void unpack8(const u32x4 w, f32x4& a, f32x4& b) { a = (f32x4){__uint_as_float(w.x << 16), __uint_as_float(w.x & 0xffff0000u), __uint_as_float(w.y << 16), __uint_as_float(w.y & 0xffff0000u)};
    b = (f32x4){__uint_as_float(w.z << 16), __uint_as_float(w.z & 0xffff0000u), __uint_as_float(w.w << 16), __uint_as_float(w.w & 0xffff0000u)}; }
struct FusedNorm {
    bf16_t* xb; bf16_t* xn; float* fout; const float* g_post; const float* g_pre; float coef; float* slots1; float* slots2; unsigned* cnt1; unsigned* cnt2; unsigned target;
    __device__ __forceinline__ void run(f32x4 (&acc)[2][2][4][2], const Unit& u, int wr, int wc, int fr, int fq, PG8_LAS unsigned char* lds, int wid, int lane) const {
        const PG8_LAS float* S = (const PG8_LAS float*)(lds + 4096);
        const int col0 = u.pn * BM + wc * 32 + 8 * fq;
        panel_ss_publish(acc, u, wr, wc, fr, fq, lds, wid, lane, slots1, cnt1);
        u32x4 pre[2][4][2];
#pragma unroll
        for (int ai = 0; ai < 2; ++ai)
#pragma unroll
            for (int m = 0; m < 4; ++m) { const size_t off = (size_t)(u.pm * BM + ai * HALF + wr * 64 + m * 16 + fr) * 1024 + col0;
#pragma unroll
                for (int bj = 0; bj < 2; ++bj) pre[ai][m][bj] = *(const u32x4*)(xb + off + bj * HALF); }
        panel_ss_collect(u, lds, wid, lane, slots1, cnt1, target);
        { f32x4 g[2][2];
#pragma unroll
          for (int bj = 0; bj < 2; ++bj)
#pragma unroll
              for (int n = 0; n < 2; ++n) g[bj][n] = *(const f32x4*)(g_post + col0 + bj * HALF + 4 * n);
#pragma unroll
          for (int ai = 0; ai < 2; ++ai)
#pragma unroll
              for (int m = 0; m < 4; ++m) { const int r = ai * HALF + wr * 64 + m * 16 + fr; const float rs = coef / sqrtf(S[r] * (1.0f / 1024.0f) + 1e-6f);
#pragma unroll
                  for (int bj = 0; bj < 2; ++bj) { f32x4 x0, x1; unpack8(pre[ai][m][bj], x0, x1);
                      acc[ai][bj][m][0] = x0 + acc[ai][bj][m][0] * g[bj][0] * rs; acc[ai][bj][m][1] = x1 + acc[ai][bj][m][1] * g[bj][1] * rs; } } }
        if (!fout) panel_ss(acc, u, wr, wc, fr, fq, lds, wid, lane, slots2, cnt2, target);
        { f32x4 g[2][2];
#pragma unroll
          for (int bj = 0; bj < 2; ++bj)
#pragma unroll
              for (int n = 0; n < 2; ++n) g[bj][n] = fout ? (f32x4){0.f, 0.f, 0.f, 0.f} : *(const f32x4*)(g_pre + col0 + bj * HALF + 4 * n);
#pragma unroll
          for (int ai = 0; ai < 2; ++ai)
#pragma unroll
              for (int m = 0; m < 4; ++m) { const int r = ai * HALF + wr * 64 + m * 16 + fr; const float rs = 1.0f / sqrtf(S[r] * (1.0f / 1024.0f) + 1e-6f);
                  const size_t off = (size_t)(u.pm * BM + r) * 1024 + col0;
#pragma unroll
                  for (int bj = 0; bj < 2; ++bj) { const f32x4 v0 = acc[ai][bj][m][0], v1 = acc[ai][bj][m][1];
                      if (fout) { *(f32x4*)(fout + off + bj * HALF) = v0; *(f32x4*)(fout + off + bj * HALF + 4) = v1; }
                      else { u32x4 wx; wx.x = cvtpk(v0[0], v0[1]); wx.y = cvtpk(v0[2], v0[3]); wx.z = cvtpk(v1[0], v1[1]); wx.w = cvtpk(v1[2], v1[3]);
                          *(u32x4*)(xb + off + bj * HALF) = wx;
                          const f32x4 y0 = v0 * g[bj][0] * rs, y1 = v1 * g[bj][1] * rs; u32x4 w; w.x = cvtpk(y0[0], y0[1]); w.y = cvtpk(y0[2], y0[3]); w.z = cvtpk(y1[0], y1[1]); w.w = cvtpk(y1[2], y1[3]);
                          *(u32x4*)(xn + off + bj * HALF) = w; } }
                  asm volatile("" ::: "memory"); } }
    }
};
struct EpiUni {
    static constexpr bool PERM = true, AFTER_DRAIN = false;
    bf16_t* O; int ldc; const float* rope; int rope_cols; int swiglu; int fused_mode; FusedNorm fn;
    __device__ __forceinline__ void operator()(const f32x4 (&acc)[2][2][4][2], const Unit& u, int wr, int wc, int fr, int fq) const {
        if (swiglu) { EpiSwiGLU e{O, ldc}; e(acc, u, wr, wc, fr, fq); }
        else { EpiBf16<true> e{O, ldc, rope, rope_cols}; e(acc, u, wr, wc, fr, fq); }
    }
    __device__ __forceinline__ void fused(f32x4 (&acc)[2][2][4][2], const Unit& u, int wr, int wc, int fr, int fq, PG8_LAS unsigned char* lds, int wid, int lane) const { fn.run(acc, u, wr, wc, fr, fq, lds, wid, lane); }
};
template <class Epi, class Sched, bool ALIGN_EPI = false, bool SP2 = false>
__device__ __forceinline__ void gemm_phase(PG8_LAS unsigned char* lds, const Gemm g, const Sched& S, const Epi& E, const int tid_in) {
    const int tid = tid_in, wid = __builtin_amdgcn_readfirstlane(tid >> 6), lane = tid & 63, wr = wid >> 2, wc = wid & 3, fr = lane & 15, fq = lane >> 4;
    const int K = g.K, nt = K / BK;
    unsigned voffA[2], voffB[2];
#pragma unroll
    for (int i = 0; i < 2; ++i) { int R, C; stage_rc(tid * 16 + i * 8192, R, C); const int Rb = Epi::PERM ? ((R & ~31) + perm32(R & 31)) : R;
        voffA[i] = (unsigned)(R * K + C) * 2u; voffB[i] = (unsigned)(Rb * K + C) * 2u; }
    const size_t kstep = (size_t)(BK * 2);
    const size_t hstep = (size_t)HALF * K * 2;
    const size_t tstep = 2 * hstep;
    const unsigned ldsw = (unsigned)wid * 1024u;
    const int aoff = lds_byte(wr * 64 + fr, fq * 8), boff = lds_byte(wc * 32 + fr, fq * 8);
#define PG8_SA(b, h) (((b) * 2 + (h)) * HTB)
#define PG8_SB(b, h) ((4 + (b) * 2 + (h)) * HTB)
#define PG8_STAGE(bufoff, gbase, voff) do { _Pragma("unroll") for (int _i = 0; _i < 2; ++_i) \
        __builtin_amdgcn_global_load_lds((const unsigned*)((const char*)(gbase) + (voff)[_i]), (PG8_LAS unsigned*)(lds + (bufoff) + ldsw + _i * 8192), 16, 0, 0); } while (0)
#define PG8_LDA(dst, b, h) do { _Pragma("unroll") for (int m = 0; m < 4; ++m) _Pragma("unroll") for (int k = 0; k < 2; ++k) dst[m][k] = *(const PG8_LAS bf16x8*)(lds + PG8_SA(b, h) + aoff + m * 2048 + k * 1024); } while (0)
#define PG8_LDB(dst, b, h) do { _Pragma("unroll") for (int n = 0; n < 2; ++n) _Pragma("unroll") for (int k = 0; k < 2; ++k) dst[n][k] = *(const PG8_LAS bf16x8*)(lds + PG8_SB(b, h) + boff + n * 2048 + k * 1024); } while (0)
#define PG8_MMA(ai, bj, At, Bt) do { __builtin_amdgcn_s_setprio(1); _Pragma("unroll") for (int m = 0; m < 4; ++m) _Pragma("unroll") for (int n = 0; n < 2; ++n) _Pragma("unroll") for (int k = 0; k < 2; ++k) \
        acc[ai][bj][m][n] = __builtin_amdgcn_mfma_f32_16x16x32_bf16(Bt[n][k], At[m][k], acc[ai][bj][m][n], 0, 0, 0); __builtin_amdgcn_s_setprio(0); } while (0)
#define PG8_WAIT_V(n) asm volatile("s_waitcnt vmcnt(" #n ")" ::: "memory")
#define PG8_WAIT_L(n) asm volatile("s_waitcnt lgkmcnt(" #n ")" ::: "memory")
#define PG8_BAR __builtin_amdgcn_s_barrier()
#define PG8_SCHED __builtin_amdgcn_sched_barrier(0)
    Unit cur, nxt; int ui = 0;
    if (!S.next(0, cur)) return;
    f32x4 acc[2][2][4][2];
#pragma unroll
    for (int a = 0; a < 2; ++a)
#pragma unroll
        for (int b = 0; b < 2; ++b)
#pragma unroll
            for (int m = 0; m < 4; ++m)
#pragma unroll
                for (int n = 0; n < 2; ++n) acc[a][b][m][n] = (f32x4){0.f, 0.f, 0.f, 0.f};
    bf16x8 At[4][2], B0[2][2], B1[2][2];
    const char* cA = (const char*)g.A + (size_t)cur.pm * tstep; const char* cB = (const char*)g.Bt + (size_t)cur.pn * tstep;
    S.a_ready(cur);
    if constexpr (SP2) {
        PG8_STAGE(PG8_SB(0, 0), cB, voffB); PG8_STAGE(PG8_SB(0, 1), cB + hstep, voffB); PG8_STAGE(PG8_SA(0, 0), cA, voffA); PG8_STAGE(PG8_SA(0, 1), cA + hstep, voffA);
        if (wr == 1) PG8_BAR;
        PG8_WAIT_V(2); PG8_BAR;
        PG8_STAGE(PG8_SB(1, 0), cB + kstep, voffB); PG8_STAGE(PG8_SA(1, 0), cA + kstep, voffA); PG8_STAGE(PG8_SB(1, 1), cB + hstep + kstep, voffB);
        PG8_WAIT_V(6); PG8_BAR;
    } else {
        PG8_STAGE(PG8_SB(0, 0), cB, voffB); PG8_STAGE(PG8_SA(0, 0), cA, voffA); PG8_STAGE(PG8_SB(0, 1), cB + hstep, voffB); PG8_STAGE(PG8_SA(0, 1), cA + hstep, voffA);
        if (wr == 1) PG8_BAR;
        PG8_WAIT_V(4); PG8_BAR;
        PG8_STAGE(PG8_SB(1, 0), cB + kstep, voffB); PG8_STAGE(PG8_SA(1, 0), cA + kstep, voffA); PG8_STAGE(PG8_SB(1, 1), cB + hstep + kstep, voffB);
        PG8_WAIT_V(6); PG8_BAR;
    }
    for (;;) {
        const bool has_next = S.next(ui + 1, nxt);
        const char* nA = has_next ? (const char*)g.A + (size_t)nxt.pm * tstep : cA; const char* nB = has_next ? (const char*)g.Bt + (size_t)nxt.pn * tstep : cB;
        for (int t = 0; t < nt; t += 2) {
            const bool last = (t == nt - 2);
            const char* a1 = cA + (size_t)(t + 1) * kstep;
            const char* a2 = last ? nA : cA + (size_t)(t + 2) * kstep; const char* b2 = last ? nB : cB + (size_t)(t + 2) * kstep;
            const char* a3 = a2 + kstep; const char* b3 = b2 + kstep;
            if (last && has_next) S.a_ready(nxt);
            if constexpr (SP2) {
            PG8_LDB(B0, 0, 0); PG8_LDB(B1, 0, 1); PG8_SCHED; PG8_LDA(At, 0, 0); PG8_STAGE(PG8_SA(1, 1), a1 + hstep, voffA);
            PG8_WAIT_V(8); PG8_WAIT_L(0); PG8_BAR; PG8_MMA(0, 0, At, B0); PG8_MMA(0, 1, At, B1); PG8_BAR; PG8_SCHED;
            PG8_LDA(At, 0, 1); PG8_STAGE(PG8_SB(0, 0), b2, voffB); PG8_STAGE(PG8_SB(0, 1), b2 + hstep, voffB); PG8_STAGE(PG8_SA(0, 0), a2, voffA);
            PG8_WAIT_V(8); PG8_WAIT_L(0); PG8_BAR; PG8_MMA(1, 0, At, B0); PG8_MMA(1, 1, At, B1); PG8_BAR; PG8_SCHED;
            PG8_LDB(B0, 1, 0); PG8_LDB(B1, 1, 1); PG8_SCHED; PG8_LDA(At, 1, 0); PG8_STAGE(PG8_SA(0, 1), a2 + hstep, voffA);
            PG8_WAIT_V(8); PG8_WAIT_L(0); PG8_BAR; PG8_MMA(0, 0, At, B0); PG8_MMA(0, 1, At, B1); PG8_BAR; PG8_SCHED;
            PG8_LDA(At, 1, 1); PG8_STAGE(PG8_SB(1, 0), b3, voffB); PG8_STAGE(PG8_SB(1, 1), b3 + hstep, voffB); PG8_STAGE(PG8_SA(1, 0), a3, voffA);
            PG8_WAIT_V(8); PG8_WAIT_L(0); PG8_BAR; PG8_MMA(1, 0, At, B0); PG8_MMA(1, 1, At, B1); PG8_BAR; PG8_SCHED;
            } else {
            PG8_LDB(B0, 0, 0); PG8_SCHED; PG8_LDA(At, 0, 0); PG8_STAGE(PG8_SA(1, 1), a1 + hstep, voffA);
            PG8_WAIT_L(8); PG8_BAR; PG8_WAIT_L(0); PG8_MMA(0, 0, At, B0); PG8_BAR; PG8_SCHED;
            PG8_LDB(B1, 0, 1); PG8_STAGE(PG8_SB(0, 0), b2, voffB);
            PG8_BAR; PG8_WAIT_L(0); PG8_MMA(0, 1, At, B1); PG8_BAR;
            PG8_LDA(At, 0, 1); PG8_STAGE(PG8_SA(0, 0), a2, voffA);
            PG8_BAR; PG8_WAIT_L(0); PG8_MMA(1, 0, At, B0); PG8_BAR; PG8_SCHED;
            PG8_STAGE(PG8_SB(0, 1), b2 + hstep, voffB);
            PG8_WAIT_V(6); PG8_BAR; PG8_MMA(1, 1, At, B1); PG8_BAR;
            PG8_LDB(B0, 1, 0); PG8_SCHED; PG8_LDA(At, 1, 0); PG8_STAGE(PG8_SA(0, 1), a2 + hstep, voffA);
            PG8_WAIT_L(8); PG8_BAR; PG8_WAIT_L(0); PG8_MMA(0, 0, At, B0); PG8_BAR; PG8_SCHED;
            PG8_LDB(B1, 1, 1); PG8_STAGE(PG8_SB(1, 0), b3, voffB);
            PG8_BAR; PG8_WAIT_L(0); PG8_MMA(0, 1, At, B1); PG8_BAR;
            PG8_LDA(At, 1, 1); PG8_STAGE(PG8_SA(1, 0), a3, voffA);
            PG8_BAR; PG8_WAIT_L(0); PG8_MMA(1, 0, At, B0); PG8_BAR; PG8_SCHED;
            PG8_STAGE(PG8_SB(1, 1), b3 + hstep, voffB);
            PG8_WAIT_V(6); PG8_BAR; PG8_MMA(1, 1, At, B1); PG8_BAR;
            }
        }
        if constexpr (ALIGN_EPI) { if (wr == 0) PG8_BAR; }
        if (!E.fused_mode) { E(acc, cur, wr, wc, fr, fq); S.done(cur); }
        if (!has_next) break;
#pragma unroll
        for (int a = 0; a < 2; ++a)
#pragma unroll
            for (int b = 0; b < 2; ++b)
#pragma unroll
                for (int m = 0; m < 4; ++m)
#pragma unroll
                    for (int n = 0; n < 2; ++n) acc[a][b][m][n] = (f32x4){0.f, 0.f, 0.f, 0.f};
        cur = nxt; cA = nA; cB = nB; ++ui;
        if constexpr (ALIGN_EPI) { if (wr == 1) PG8_BAR; }
    }
    PG8_WAIT_V(0);
    if constexpr (!ALIGN_EPI) { if (wr == 0) PG8_BAR; }
    PG8_BAR;
    if (E.fused_mode) { E.fused(acc, cur, wr, wc, fr, fq, lds, wid, lane); S.done(cur); }
#undef PG8_SA
#undef PG8_SB
#undef PG8_STAGE
#undef PG8_LDA
#undef PG8_LDB
#undef PG8_MMA
#undef PG8_WAIT_V
#undef PG8_WAIT_L
#undef PG8_BAR
#undef PG8_SCHED
}
}

constexpr int D = 1024, SEQ = 2048, BATCH = 8, M = BATCH * SEQ, FF = 2816, NPROJ = 2560, DEPTH = 4;
constexpr int NWAVES = 8, NTHREADS = NWAVES * 64;
typedef unsigned short bf16;
typedef short bf16x8 __attribute__((ext_vector_type(8)));
typedef float f32x16 __attribute__((ext_vector_type(16)));
typedef float f32x4 __attribute__((ext_vector_type(4)));
typedef unsigned u32x4 __attribute__((ext_vector_type(4)));
typedef unsigned u32x2 __attribute__((ext_vector_type(2)));
typedef short s16x4 __attribute__((ext_vector_type(4)));
#define MFMA32(a, b, c) __builtin_amdgcn_mfma_f32_32x32x16_bf16((a), (b), (c), 0, 0, 0)

constexpr size_t MiB = 1u << 20;
constexpr size_t WL_GU0 = 0, WL_GU1 = 11534336, WL_D0 = 2 * 11534336, WL_D1 = WL_D0 + 5767168, WL_IN = WL_D1 + 5767168, WL_OUT = WL_IN + 5242880, WL_BYTES = 40 * MiB;
static_assert(WL_OUT + 2097152 == WL_BYTES, "per-layer weight block");
constexpr size_t WS_W = 0, WS_ROPE = 160 * MiB, WS_XN = 161 * MiB, WS_HB = 193 * MiB, WS_PROJ = WS_HB, WS_F = 281 * MiB, WS_MIX = 313 * MiB, WS_CTL = 345 * MiB, CTL_CNT1 = 16384, CTL_CNT2 = 32768, CTL_Q = 49152, CTL_BYTES = 53248, WS_SLOT1 = 346 * MiB, WS_SLOT2 = 347 * MiB, WS_END = 348 * MiB;

constexpr int LDS_BYTES = 147456;
constexpr int LDS_MISC = 131072 + 320;

__device__ __forceinline__ float wave_sum(float v, int lane) {
#pragma unroll
    for (int o = 1; o < 64; o <<= 1) v += shx(v, o, lane);
    return v;
}

template <int MODE> __device__ __forceinline__ int dest_row(int n, int row_off) {
    if (MODE == 1) return 256 * (n >> 7) + row_off + (n & 127);
    if (MODE == 2) { if (n >= 1024) return n; const int d = n & 63; return (n & ~63) + (d < 32 ? 2 * d : 2 * (d - 32) + 1); }
    return n + row_off;
}
template <int MODE> __device__ __forceinline__ void transpose_item(const float* W, int K, int N, bf16* WT, int row_off, LAS float* scr, int item, int lane) {
    const int nblk = N / 32, kb = item / nblk, nb = item % nblk, k0 = 64 * kb, n0 = 32 * nb;
    float wv[32];
#pragma unroll
    for (int i = 0; i < 32; ++i) wv[i] = __builtin_nontemporal_load(W + (size_t)(k0 + 2 * i + (lane >> 5)) * N + n0 + (lane & 31));
#pragma unroll
    for (int i = 0; i < 32; ++i) scr[(2 * i + (lane >> 5)) * 33 + (lane & 31)] = wv[i];
    asm volatile("s_waitcnt lgkmcnt(0)" ::: "memory");
    const int c = lane & 7;
#pragma unroll
    for (int j = 0; j < 4; ++j) { const int n = (lane >> 3) + 8 * j; const LAS float* s = scr + (8 * c) * 33 + n;
        u32x4 o; o.x = cvtpk(s[0 * 33], s[1 * 33]); o.y = cvtpk(s[2 * 33], s[3 * 33]); o.z = cvtpk(s[4 * 33], s[5 * 33]); o.w = cvtpk(s[6 * 33], s[7 * 33]);
        *(u32x4*)(WT + (size_t)dest_row<MODE>(n0 + n, row_off) * K + k0 + 8 * c) = o; }
    asm volatile("s_waitcnt lgkmcnt(0)" ::: "memory");
}

struct Params {
    const float* x; const float* norm_g; const float* w_gate; const float* w_up; const float* w_down;
    const float* ab_w_in; const float* ab_w_out; const float* conv_w; const float* conv_b; const float* conv_ln_g; const float* conv_ln_b;
    const float* cd_w_in; const float* cd_w_out; const float* sgu_ln_g; const float* sgu_ln_b; const float* sgu_w; const float* sgu_b;
    float* out; unsigned char* ws;
    int ph_lo, ph_hi;
    float inv_freq[32];
};

typedef const __attribute__((address_space(4))) Params* PP;
constexpr int CV_I_G = (D / 64) * (FF / 32), CV_I_D = (FF / 64) * (D / 32), CV_I_IN = (D / 64) * (NPROJ / 32), CV_I_OUT = (D / 64) * (D / 32);
constexpr int CV_PER_LAYER = 4 * CV_I_G + 2 * CV_I_D + CV_I_IN + CV_I_OUT;
__device__ __forceinline__ void convert_wave_item(PP p, int L, int r, LAS float* scr, int lane) {
    constexpr int I_G = CV_I_G, I_D = CV_I_D, I_IN = CV_I_IN;
    unsigned char* wl = p->ws + WS_W + (size_t)L * WL_BYTES;
    if (r < 4 * I_G) { const int f = r / (2 * I_G); r -= f * 2 * I_G; const int up = r / I_G; r -= up * I_G;
        const float* W = (up ? p->w_up : p->w_gate) + (size_t)(L * 2 + f) * D * FF;
        transpose_item<1>(W, D, FF, (bf16*)(wl + (f ? WL_GU1 : WL_GU0)), up ? 128 : 0, scr, r, lane); return; }
    r -= 4 * I_G;
    if (r < 2 * I_D) { const int f = r / I_D; r -= f * I_D;
        transpose_item<0>(p->w_down + (size_t)(L * 2 + f) * FF * D, FF, D, (bf16*)(wl + (f ? WL_D1 : WL_D0)), 0, scr, r, lane); return; }
    r -= 2 * I_D;
    const int i = L >> 1; const bool even = (L & 1) == 0;
    if (r < I_IN) { const float* W = (even ? p->ab_w_in : p->cd_w_in) + (size_t)i * D * NPROJ;
        if (even) transpose_item<2>(W, D, NPROJ, (bf16*)(wl + WL_IN), 0, scr, r, lane); else transpose_item<0>(W, D, NPROJ, (bf16*)(wl + WL_IN), 0, scr, r, lane); return; }
    r -= I_IN;
    transpose_item<0>((even ? p->ab_w_out : p->cd_w_out) + (size_t)i * D * D, D, D, (bf16*)(wl + WL_OUT), 0, scr, r, lane);
}
__device__ __forceinline__ void prologue_weights(PP p, LAS unsigned char* lds, int gw, int NGW, int wave, int lane) {
    LAS float* scr = (LAS float*)(lds + wave * 16384);
    const int nit = (NGW == 256 * NWAVES) ? 2816 : DEPTH * CV_PER_LAYER;
    for (int it = gw; it < nit; it += NGW) convert_wave_item(p, it / CV_PER_LAYER, it % CV_PER_LAYER, scr, lane);
}
__device__ __forceinline__ void prologue_rope(PP p, int gtid, int NGT) {
    float* tab = (float*)(p->ws + WS_ROPE);
    for (int e = gtid; e < SEQ * 32; e += NGT) { const int pos = e >> 5, i = e & 31;
        const float ang = (float)pos * p->inv_freq[i];
        double rev = (double)ang * 0.15915494309189533577; rev -= __builtin_rint(rev);
        const float fr = (float)rev;
        tab[2 * e] = __builtin_amdgcn_cosf(fr); tab[2 * e + 1] = __builtin_amdgcn_sinf(fr); }
}

__device__ __forceinline__ void row_pass(const float* xsrc, float* xdst, const bf16* F, float coef, const float* g_post, const float* g_pre, bf16* XN, int gw, int NGW, int lane) {
    for (int m = gw; m < M; m += NGW) {
        const f32x4* xr = (const f32x4*)(xsrc + (size_t)m * D) + lane;
        f32x4 v[4];
#pragma unroll
        for (int j = 0; j < 4; ++j) v[j] = xr[64 * j];
        if (F) {
            const u32x2* fr = (const u32x2*)(F + (size_t)m * D) + lane; f32x4 f[4]; float ss = 0.f;
#pragma unroll
            for (int j = 0; j < 4; ++j) { const u32x2 w = fr[64 * j]; f[j] = (f32x4){bflo(w.x), bfhi(w.x), bflo(w.y), bfhi(w.y)}; ss += (f[j].x * f[j].x + f[j].y * f[j].y) + (f[j].z * f[j].z + f[j].w * f[j].w); }
            const float rs = coef / sqrtf(wave_sum(ss, lane) * (1.f / D) + 1e-6f);
#pragma unroll
            for (int j = 0; j < 4; ++j) { const f32x4 g = ((const f32x4*)g_post)[lane + 64 * j]; v[j] = v[j] + f[j] * g * rs; }
        }
        u32x2* xo = (u32x2*)((bf16*)xdst + (size_t)m * D) + lane;
#pragma unroll
        for (int j = 0; j < 4; ++j) { u32x2 w; w.x = cvtpk(v[j].x, v[j].y); w.y = cvtpk(v[j].z, v[j].w); xo[64 * j] = w; }
        if (XN) {
            float ss = 0.f;
#pragma unroll
            for (int j = 0; j < 4; ++j) ss += (v[j].x * v[j].x + v[j].y * v[j].y) + (v[j].z * v[j].z + v[j].w * v[j].w);
            const float rs = 1.0f / sqrtf(wave_sum(ss, lane) * (1.f / D) + 1e-6f);
            u32x2* o8 = (u32x2*)(XN + (size_t)m * D) + lane;
#pragma unroll
            for (int j = 0; j < 4; ++j) { const f32x4 g = ((const f32x4*)g_pre)[lane + 64 * j]; const f32x4 y = v[j] * g * rs; u32x2 w; w.x = cvtpk(y.x, y.y); w.y = cvtpk(y.z, y.w); o8[64 * j] = w; }
        }
    }
}

namespace mx {
constexpr int KP = 144, TILEB = 64 * KP;
constexpr int OFF_K = 0, OFF_V = 3 * TILEB, OFF_KM = 6 * TILEB, OFF_PART = OFF_KM + 8 * 64 * 4;
constexpr int OFF_FLAG = OFF_PART + 8 * 8 * 64 * 4;
constexpr int MX_BYTES = OFF_FLAG + 64;
__device__ __forceinline__ int crow(int r, int hi) { return (r & 3) + 8 * (r >> 2) + 4 * hi; }
__device__ __forceinline__ s16x4 vtr(LAS const unsigned char* p) { typedef short v4i16_t __attribute__((ext_vector_type(4))); return __builtin_bit_cast(s16x4, __builtin_amdgcn_ds_read_tr16_b64_v4i16((LAS v4i16_t*)p)); }

__device__ __forceinline__ void tile_load(const bf16* Kg, const bf16* Vg, int row0, int tid, u32x4& kr, u32x4& vr) {
    const int row = tid >> 3, ch = tid & 7;
    kr = *(const u32x4*)(Kg + (size_t)(row0 + row) * NPROJ + ch * 8);
    vr = *(const u32x4*)(Vg + (size_t)(row0 + row) * NPROJ + ch * 8);
}
__device__ __forceinline__ void tile_store(LAS unsigned char* lds, int slot_off, int tid, const u32x4& kr, const u32x4& vr) {
    const int row = tid >> 3, ch = tid & 7;
    *(LAS u32x4*)(lds + OFF_K + slot_off + row * KP + ch * 16) = kr;
    *(LAS u32x4*)(lds + OFF_V + slot_off + row * KP + ch * 16) = vr;
}
__device__ __forceinline__ void qk_tile(LAS const unsigned char* Kb, const bf16x8 (&qr)[4], int r32, int hi, f32x16& p0, f32x16& p1) {
#pragma unroll
    for (int r = 0; r < 16; ++r) { p0[r] = 0.f; p1[r] = 0.f; }
#pragma unroll
    for (int d0 = 0; d0 < 4; ++d0) {
        const bf16x8 k0 = *(LAS const bf16x8*)(Kb + r32 * KP + d0 * 32 + hi * 16);
        const bf16x8 k1 = *(LAS const bf16x8*)(Kb + (32 + r32) * KP + d0 * 32 + hi * 16);
        p0 = MFMA32(k0, qr[d0], p0); p1 = MFMA32(k1, qr[d0], p1);
    }
}
__device__ __forceinline__ void pv_tile(LAS const unsigned char* Vb, int lane, const f32x16& p0, const f32x16& p1, f32x16 (&o)[2]) {
    const int i = lane & 15, q4 = i >> 2, pp = i & 3, g1 = (lane >> 4) & 1, hi = lane >> 5;
    LAS const unsigned char* vb = Vb + (4 * hi + q4) * KP + g1 * 32 + pp * 8;
#pragma unroll
    for (int sub = 0; sub < 2; ++sub)
#pragma unroll
        for (int s = 0; s < 2; ++s) {
            u32x4 pk;
            if (sub == 0) { pk.x = cvtpk(p0[8 * s], p0[8 * s + 1]); pk.y = cvtpk(p0[8 * s + 2], p0[8 * s + 3]); pk.z = cvtpk(p0[8 * s + 4], p0[8 * s + 5]); pk.w = cvtpk(p0[8 * s + 6], p0[8 * s + 7]); }
            else          { pk.x = cvtpk(p1[8 * s], p1[8 * s + 1]); pk.y = cvtpk(p1[8 * s + 2], p1[8 * s + 3]); pk.z = cvtpk(p1[8 * s + 4], p1[8 * s + 5]); pk.w = cvtpk(p1[8 * s + 6], p1[8 * s + 7]); }
            const bf16x8 pb = __builtin_bit_cast(bf16x8, pk);
#pragma unroll
            for (int d0 = 0; d0 < 2; ++d0) {
                const s16x4 lo = vtr(vb + (32 * sub + 16 * s) * KP + d0 * 64);
                const s16x4 hh = vtr(vb + (32 * sub + 16 * s + 8) * KP + d0 * 64);
                const bf16x8 va = {lo[0], lo[1], lo[2], lo[3], hh[0], hh[1], hh[2], hh[3]};
                o[d0] = MFMA32(va, pb, o[d0]);
            }
        }
}
__device__ __forceinline__ void store_ot(bf16* dst  , const f32x16 (&o)[2], int hi, float scale) {
#pragma unroll
    for (int d0 = 0; d0 < 2; ++d0)
#pragma unroll
        for (int g4 = 0; g4 < 4; ++g4) { u32x2 w; w.x = cvtpk(o[d0][4 * g4] * scale, o[d0][4 * g4 + 1] * scale); w.y = cvtpk(o[d0][4 * g4 + 2] * scale, o[d0][4 * g4 + 3] * scale);
            *(u32x2*)(dst + 32 * d0 + 8 * g4 + 4 * hi) = w; }
}

#ifndef MX_NO_SCHED
#define MX_SCHED() do { __builtin_amdgcn_sched_group_barrier(0x100, 8, 0); _Pragma("unroll") for (int i_ = 0; i_ < 8; ++i_) { __builtin_amdgcn_sched_group_barrier(0x008, 1, 0); __builtin_amdgcn_sched_group_barrier(0x002, 20, 0); } } while (0)
#else
#define MX_SCHED() do {} while (0)
#endif
template <bool DIAG> __device__ __forceinline__ void moba_softmax(f32x16& p0, f32x16& p1, int t, int qrel, int hi, int lane, bool mysel, float C, float& mrun, float& lrun, f32x16 (&o)[2]) {
    float bias = 0.f;
    if (DIAG) {
#pragma unroll
        for (int r = 0; r < 16; ++r) { const int kv = 64 * t + crow(r, hi); p0[r] = kv <= qrel ? p0[r] : -INFINITY; p1[r] = kv + 32 <= qrel ? p1[r] : -INFINITY; }
    } else bias = mysel ? 0.f : -INFINITY;
    float rm = fmaxf(p0[0], p1[0]);
#pragma unroll
    for (int r = 1; r < 16; ++r) rm = fmaxf(rm, fmaxf(p0[r], p1[r]));
    rm = fmaxf(rm, shx(rm, 32, lane));
    const float mnew = fmaxf(mrun, rm * C + bias); const float alpha = fexp2(mrun - mnew);
#pragma unroll
    for (int r = 0; r < 16; ++r) { o[0][r] *= alpha; o[1][r] *= alpha; }
    mrun = mnew; const float nb = bias - mnew; float rs = 0.f;
#pragma unroll
    for (int r = 0; r < 16; ++r) { p0[r] = fexp2(__builtin_fmaf(p0[r], C, nb)); p1[r] = fexp2(__builtin_fmaf(p1[r], C, nb)); rs += p0[r] + p1[r]; }
    lrun = lrun * alpha + rs;
}

__device__ __forceinline__ void moba_unit(LAS unsigned char* lds, const bf16* PROJ, bf16* MIX, int b, int h, int j, int tid) {
    const int lane = tid & 63, wid = __builtin_amdgcn_readfirstlane(tid >> 6), r32 = lane & 31, hi = lane >> 5;
    const size_t rowbase = (size_t)b * SEQ; const int q0 = 256 * j;
    const bf16* Kg = PROJ + rowbase * NPROJ + 512 + h * 64; const bf16* Vg = PROJ + rowbase * NPROJ + 1024 + h * 64;
    const bf16* Qp = PROJ + (rowbase + q0 + 32 * wid + r32) * NPROJ + h * 64;
    bf16x8 qr[4];
#pragma unroll
    for (int d0 = 0; d0 < 4; ++d0) qr[d0] = *(const bf16x8*)(Qp + 16 * d0 + 8 * hi);
    u32x4 kr, vr, kr1, vr1; tile_load(Kg, Vg, q0, tid, kr, vr); tile_load(Kg, Vg, q0 + 64, tid, kr1, vr1);
    LAS float* km = (LAS float*)(lds + OFF_KM); LAS float* part = (LAS float*)(lds + OFF_PART);
    { const int ch = tid & 7, rr = tid >> 3;
      for (int n = 0; n < j; ++n) { float a[8];
#pragma unroll
        for (int e = 0; e < 8; ++e) a[e] = 0.f;
#pragma unroll
        for (int i = 0; i < 4; ++i) { const u32x4 v = *(const u32x4*)(Kg + (size_t)(256 * n + rr + 64 * i) * NPROJ + ch * 8);
            a[0] += bflo(v.x); a[1] += bfhi(v.x); a[2] += bflo(v.y); a[3] += bfhi(v.y); a[4] += bflo(v.z); a[5] += bfhi(v.z); a[6] += bflo(v.w); a[7] += bfhi(v.w); }
#pragma unroll
        for (int e = 0; e < 8; ++e) { a[e] += shx(a[e], 8, lane); a[e] += shx(a[e], 16, lane); a[e] += shx(a[e], 32, lane); }
        if (lane < 8) {
#pragma unroll
            for (int e = 0; e < 8; ++e) part[(n * 8 + wid) * 64 + lane * 8 + e] = a[e]; } }
      __syncthreads();
      if (tid < 64) for (int n = 0; n < j; ++n) { float s = 0.f;
#pragma unroll
        for (int w = 0; w < 8; ++w) s += part[(n * 8 + w) * 64 + tid];
        km[n * 64 + tid] = s * (1.0f / 256.0f); }
      tile_store(lds, 0, tid, kr, vr); tile_store(lds, TILEB, tid, kr1, vr1);
      __syncthreads(); }
    float gt[8];
#pragma unroll
    for (int n = 0; n < 8; ++n) { gt[n] = -INFINITY;
        if (n < j) { float s = 0.f;
#pragma unroll
            for (int d0 = 0; d0 < 4; ++d0) { const LAS f32x4* kp = (const LAS f32x4*)(km + n * 64 + 16 * d0 + 8 * hi); const f32x4 k0 = kp[0], k1 = kp[1]; const u32x4 qq = __builtin_bit_cast(u32x4, qr[d0]);
                s += bflo(qq.x) * k0.x + bfhi(qq.x) * k0.y + bflo(qq.y) * k0.z + bfhi(qq.y) * k0.w + bflo(qq.z) * k1.x + bfhi(qq.z) * k1.y + bflo(qq.w) * k1.z + bfhi(qq.w) * k1.w; }
            s += shx(s, 32, lane); gt[n] = s; } }
    unsigned sel = 0u;
#pragma unroll
    for (int n = 0; n < 8; ++n) { int cnt = 0;
#pragma unroll
        for (int n2 = 0; n2 < 8; ++n2) cnt += (gt[n2] > gt[n] || (gt[n2] == gt[n] && n2 < n)) ? 1 : 0;
        if (n < j && cnt < 3) sel |= 1u << n; }
    const float C = 0.125f * 1.4426950408889634f;
    float mrun = -INFINITY, lrun = 0.f; f32x16 o[2];
#pragma unroll
    for (int r = 0; r < 16; ++r) { o[0][r] = 0.f; o[1][r] = 0.f; }
    const int NT = 4 * (j + 1); const int qrel = 32 * wid + r32;
    f32x16 pc0, pc1; qk_tile(lds + OFF_K, qr, r32, hi, pc0, pc1);
    int sc = 0, sn = TILEB, s2 = 2 * TILEB;
    int t = 0;
    for (; t < NT - 1; ++t) {
        if (t + 2 < NT) { const int t2 = t + 2; const int row2 = t2 < 4 ? q0 + 64 * t2 : 256 * ((t2 - 4) >> 2) + 64 * ((t2 - 4) & 3); tile_load(Kg, Vg, row2, tid, kr, vr); }
        f32x16 pn0, pn1;
        if (t < 4) { qk_tile(lds + OFF_K + sn, qr, r32, hi, pn0, pn1); moba_softmax<true>(pc0, pc1, t, qrel, hi, lane, true, C, mrun, lrun, o); pv_tile(lds + OFF_V + sc, lane, pc0, pc1, o); MX_SCHED(); }
        else { const bool mysel = ((sel >> ((t - 4) >> 2)) & 1u) != 0u;
               qk_tile(lds + OFF_K + sn, qr, r32, hi, pn0, pn1); moba_softmax<false>(pc0, pc1, t, qrel, hi, lane, mysel, C, mrun, lrun, o); pv_tile(lds + OFF_V + sc, lane, pc0, pc1, o); MX_SCHED(); }
        if (t + 2 < NT) tile_store(lds, s2, tid, kr, vr);
        __syncthreads();
        pc0 = pn0; pc1 = pn1; { const int tmp = sc; sc = sn; sn = s2; s2 = tmp; }
    }
    if (t < 4) moba_softmax<true>(pc0, pc1, t, qrel, hi, lane, true, C, mrun, lrun, o);
    else moba_softmax<false>(pc0, pc1, t, qrel, hi, lane, ((sel >> ((t - 4) >> 2)) & 1u) != 0u, C, mrun, lrun, o);
    pv_tile(lds + OFF_V + sc, lane, pc0, pc1, o);
    __syncthreads();
    lrun += shx(lrun, 32, lane);
    store_ot(MIX + (rowbase + q0 + 32 * wid + r32) * D + h * 64, o, hi, 1.0f / lrun);
}

__device__ __forceinline__ void sb_sub(f32x16& p, int kvbase, int qpos, int hi, int lane, float& carry, bool needmask) {
    const float LOG2E = 1.4426950408889634f, LN2 = 0.6931471805599453f;
    float L[16]; bool valid[16];
#pragma unroll
    for (int r = 0; r < 16; ++r) { const float z = p[r] * 0.125f; const float e = fexp2(-fabsf(z) * LOG2E); const float sp = fmaxf(z, 0.f) + flog2(1.0f + e) * LN2;
        valid[r] = !needmask || (kvbase + crow(r, hi) < qpos); L[r] = valid[r] ? -sp : 0.f; p[r] = z - sp; }
    float T[4], U[4], X[4];
#pragma unroll
    for (int G = 0; G < 4; ++G) { T[G] = (L[4 * G] + L[4 * G + 1]) + (L[4 * G + 2] + L[4 * G + 3]); U[G] = shx(T[G], 32, lane); X[G] = T[G] + U[G]; }
    float tail[4]; tail[3] = 0.f; tail[2] = X[3]; tail[1] = X[3] + X[2]; tail[0] = X[3] + X[2] + X[1];
#pragma unroll
    for (int G = 0; G < 4; ++G) { const float E = carry + tail[G] + (hi == 0 ? U[G] : 0.f);
        const float e3 = E, e2 = E + L[4 * G + 3], e1 = e2 + L[4 * G + 2], e0 = e1 + L[4 * G + 1];
        p[4 * G + 3] = valid[4 * G + 3] ? fexp2((p[4 * G + 3] + e3) * LOG2E) : 0.f; p[4 * G + 2] = valid[4 * G + 2] ? fexp2((p[4 * G + 2] + e2) * LOG2E) : 0.f;
        p[4 * G + 1] = valid[4 * G + 1] ? fexp2((p[4 * G + 1] + e1) * LOG2E) : 0.f; p[4 * G]     = valid[4 * G]     ? fexp2((p[4 * G]     + e0) * LOG2E) : 0.f; }
    carry += (X[0] + X[1]) + (X[2] + X[3]);
}
__device__ __forceinline__ void sb_unit(LAS unsigned char* lds, const bf16* PROJ, bf16* MIX, int b, int h, int jq, int tid) {
    const int lane = tid & 63, wid = __builtin_amdgcn_readfirstlane(tid >> 6), r32 = lane & 31, hi = lane >> 5;
    const size_t rowbase = (size_t)b * SEQ; const int q0 = 256 * jq;
    const bf16* Kg = PROJ + rowbase * NPROJ + 1536 + h * 64; const bf16* Vg = PROJ + rowbase * NPROJ + 2048 + h * 64;
    const bf16* Qp = PROJ + (rowbase + q0 + 32 * wid + r32) * NPROJ + 1024 + h * 64;
    bf16x8 qr[4];
#pragma unroll
    for (int d0 = 0; d0 < 4; ++d0) qr[d0] = *(const bf16x8*)(Qp + 16 * d0 + 8 * hi);
    const int NT = 4 * jq + 4;
    u32x4 kr, vr, kr1, vr1; tile_load(Kg, Vg, 64 * (NT - 1), tid, kr, vr); tile_load(Kg, Vg, 64 * (NT - 2), tid, kr1, vr1);
    tile_store(lds, 0, tid, kr, vr); tile_store(lds, TILEB, tid, kr1, vr1);
    __syncthreads();
    f32x16 o[2];
#pragma unroll
    for (int r = 0; r < 16; ++r) { o[0][r] = 0.f; o[1][r] = 0.f; }
    float carry = 0.f; const int Q0 = q0 + 32 * wid, qpos = Q0 + r32;
    LAS unsigned* flg = (LAS unsigned*)(lds + OFF_FLAG); bool wdone = false;
    f32x16 pc0, pc1; bool havepc = (64 * (NT - 1) <= Q0 + 30);
    if (havepc) qk_tile(lds + OFF_K, qr, r32, hi, pc0, pc1);
    int sc = 0, sn = TILEB, s2 = 2 * TILEB;
    for (int t = 0; t < NT; ++t) {
        const int kt = NT - 1 - t;
        if (t + 2 < NT) tile_load(Kg, Vg, 64 * (kt - 2), tid, kr, vr);
        const bool cur = havepc && !wdone, nxt = (t + 1 < NT) && (64 * (kt - 1) <= Q0 + 30) && !wdone;
        const bool needmask = (64 * kt + 63 >= Q0);
        f32x16 pn0, pn1;
        if (cur && nxt) {
            qk_tile(lds + OFF_K + sn, qr, r32, hi, pn0, pn1);
            sb_sub(pc1, 64 * kt + 32, qpos, hi, lane, carry, needmask);
            sb_sub(pc0, 64 * kt, qpos, hi, lane, carry, needmask);
            pv_tile(lds + OFF_V + sc, lane, pc0, pc1, o);
            MX_SCHED();
        } else if (cur) {
            sb_sub(pc1, 64 * kt + 32, qpos, hi, lane, carry, needmask);
            sb_sub(pc0, 64 * kt, qpos, hi, lane, carry, needmask);
            pv_tile(lds + OFF_V + sc, lane, pc0, pc1, o);
        } else if (nxt) qk_tile(lds + OFF_K + sn, qr, r32, hi, pn0, pn1);
        if (cur) wdone = (__ballot(carry > -105.0f) == 0ull);
        const int fb = t & 1;
        if (lane == 0) flg[fb * 8 + wid] = wdone ? 1u : 0u;
        if (t + 2 < NT) tile_store(lds, s2, tid, kr, vr);
        __syncthreads();
        const u32x4 f0 = *(const LAS u32x4*)(flg + fb * 8), f1 = *(const LAS u32x4*)(flg + fb * 8 + 4);
        if ((f0.x & f0.y & f0.z & f0.w & f1.x & f1.y & f1.z & f1.w) != 0u) break;
        pc0 = pn0; pc1 = pn1; havepc = nxt; { const int tmp = sc; sc = sn; sn = s2; s2 = tmp; }
    }
    __syncthreads();
    store_ot(MIX + (rowbase + q0 + 32 * wid + r32) * D + 512 + h * 64, o, hi, 1.0f);
}

__device__ __forceinline__ void conv_item(LAS unsigned char* lds, const bf16* PROJ, bf16* MIX, const float* cw, const float* cb, const float* lg, const float* lb, int item, int tid) {
    const int lane = tid & 63, wid = __builtin_amdgcn_readfirstlane(tid >> 6), c = tid;
    const int row0 = 32 * item, pos0 = row0 & (SEQ - 1);
    float w[31];
#pragma unroll
    for (int k = 0; k < 31; ++k) w[k] = cw[k * 512 + c];
    float hw[62];
#pragma unroll
    for (int i = 0; i < 62; ++i) { float hv = 0.f;
        if (pos0 - 30 + i >= 0) { const bf16* rp = PROJ + (size_t)(row0 - 30 + i) * NPROJ; const float a = bf2f(rp[1536 + c]), g = bf2f(rp[2048 + c]); hv = a * sigmoidf_(g); }
        hw[i] = hv; }
    float acc[32]; const float bias = cb[c];
#pragma unroll
    for (int tk = 0; tk < 32; ++tk) { float s = bias;
#pragma unroll
        for (int k = 0; k < 31; ++k) s += w[k] * hw[tk + k];
        acc[tk] = s; }
    LAS float* cbuf = (LAS float*)lds; LAS float* st = (LAS float*)(lds + 32 * 512 * 4);
#pragma unroll
    for (int tk = 0; tk < 32; ++tk) cbuf[tk * 512 + c] = acc[tk];
    __syncthreads();
#pragma unroll
    for (int q = 0; q < 4; ++q) { const int tk = 4 * wid + q; float v[8]; float s = 0.f;
#pragma unroll
        for (int i = 0; i < 8; ++i) { v[i] = cbuf[tk * 512 + lane + 64 * i]; s += v[i]; }
        const float mean = wave_sum(s, lane) * (1.f / 512.f); float s2 = 0.f;
#pragma unroll
        for (int i = 0; i < 8; ++i) { const float d = v[i] - mean; s2 += d * d; }
        const float rstd = 1.0f / sqrtf(wave_sum(s2, lane) * (1.f / 512.f) + 1e-5f);
        if (lane == 0) { st[2 * tk] = mean; st[2 * tk + 1] = rstd; } }
    __syncthreads();
    const float g = lg[c], bb = lb[c];
#pragma unroll
    for (int tk = 0; tk < 32; ++tk) { const float y = (acc[tk] - st[2 * tk]) * st[2 * tk + 1] * g + bb; const float ov = siluf_(y);
        MIX[(size_t)(row0 + tk) * D + 512 + c] = (bf16)(cvtpk(ov, 0.f) & 0xffffu); }
    __syncthreads();
}

constexpr int SGP = 272;
__device__ __forceinline__ void sgu_item(LAS unsigned char* lds, const bf16* PROJ, bf16* MIX, const float* lg, const float* lb, const float* ws_, const float* bs_, int item, int tid) {
    const int lane = tid & 63, wid = __builtin_amdgcn_readfirstlane(tid >> 6), r32 = lane & 31, hi = lane >> 5;
    const size_t row0 = (size_t)item * 128;
    LAS float* st = (LAS float*)lds;
    LAS unsigned char* vnT = lds + 1024;
    for (int q = 0; q < 16; ++q) { const int s = 16 * wid + q; const u32x4 v = *(const u32x4*)(PROJ + (row0 + s) * NPROJ + 512 + lane * 8);
        float x[8] = {bflo(v.x), bfhi(v.x), bflo(v.y), bfhi(v.y), bflo(v.z), bfhi(v.z), bflo(v.w), bfhi(v.w)}; float sm = 0.f;
#pragma unroll
        for (int e = 0; e < 8; ++e) { x[e] = geluf_(x[e]); sm += x[e]; }
        const float mean = wave_sum(sm, lane) * (1.f / 512.f); float s2 = 0.f;
#pragma unroll
        for (int e = 0; e < 8; ++e) { const float d = x[e] - mean; s2 += d * d; }
        const float rstd = 1.0f / sqrtf(wave_sum(s2, lane) * (1.f / 512.f) + 1e-5f);
        if (lane == 0) { st[2 * s] = mean; st[2 * s + 1] = rstd; } }
    __syncthreads();
    const int wt = wid & 3, wcg = wid >> 2;
    for (int g = 0; g < 4; ++g) {
        { const int s = tid & 127, cs = tid >> 7; const float mean = st[2 * s], rstd = st[2 * s + 1];
          const bf16* vp = PROJ + (row0 + s) * NPROJ + 512 + 128 * g + 32 * cs;
#pragma unroll
          for (int q = 0; q < 4; ++q) { const u32x4 v = *(const u32x4*)(vp + 8 * q);
              float x[8] = {bflo(v.x), bfhi(v.x), bflo(v.y), bfhi(v.y), bflo(v.z), bfhi(v.z), bflo(v.w), bfhi(v.w)};
#pragma unroll
              for (int e = 0; e < 8; ++e) { const int cl = 32 * cs + 8 * q + e; const int cgl = 128 * g + cl; const float y = (geluf_(x[e]) - mean) * rstd * lg[cgl] + lb[cgl];
                  *(LAS unsigned short*)(vnT + cl * SGP + 2 * s) = (unsigned short)(cvtpk(y, 0.f) & 0xffffu); } } }
        __syncthreads();
        f32x16 acc[2];
#pragma unroll
        for (int r = 0; r < 16; ++r) { acc[0][r] = 0.f; acc[1][r] = 0.f; }
        const int trow = 32 * wt + r32; const float* wrow = ws_ + ((size_t)g * 128 + trow) * 128;
        for (int ks = 0; ks < 2 * (wt + 1); ++ks) { const int s0 = 16 * ks + 8 * hi;
            const f32x4 w0 = *(const f32x4*)(wrow + s0), w1 = *(const f32x4*)(wrow + s0 + 4);
            u32x4 pk; pk.x = cvtpk(s0 + 0 <= trow ? w0.x : 0.f, s0 + 1 <= trow ? w0.y : 0.f); pk.y = cvtpk(s0 + 2 <= trow ? w0.z : 0.f, s0 + 3 <= trow ? w0.w : 0.f);
            pk.z = cvtpk(s0 + 4 <= trow ? w1.x : 0.f, s0 + 5 <= trow ? w1.y : 0.f); pk.w = cvtpk(s0 + 6 <= trow ? w1.z : 0.f, s0 + 7 <= trow ? w1.w : 0.f);
            const bf16x8 wa = __builtin_bit_cast(bf16x8, pk);
#pragma unroll
            for (int ct = 0; ct < 2; ++ct) { const bf16x8 vb = *(LAS const bf16x8*)(vnT + (64 * wcg + 32 * ct + r32) * SGP + s0 * 2); acc[ct] = MFMA32(vb, wa, acc[ct]); } }
        { const int t = 32 * wt + r32; const float bias = bs_[g * 128 + t]; const bf16* up = PROJ + (row0 + t) * NPROJ + 128 * g + 64 * wcg + 4 * hi; bf16* op = MIX + (row0 + t) * D + 128 * g + 64 * wcg + 4 * hi;
#pragma unroll
          for (int ct = 0; ct < 2; ++ct)
#pragma unroll
            for (int g4 = 0; g4 < 4; ++g4) { const u32x2 uw = *(const u32x2*)(up + 32 * ct + 8 * g4);
                const float o0 = geluf_(bflo(uw.x)) * (acc[ct][4 * g4] + bias), o1 = geluf_(bfhi(uw.x)) * (acc[ct][4 * g4 + 1] + bias), o2 = geluf_(bflo(uw.y)) * (acc[ct][4 * g4 + 2] + bias), o3 = geluf_(bfhi(uw.y)) * (acc[ct][4 * g4 + 3] + bias);
                u32x2 w; w.x = cvtpk(o0, o1); w.y = cvtpk(o2, o3); *(u32x2*)(op + 32 * ct + 8 * g4) = w; } }
        __syncthreads();
    }
}
}


#define RLX_AGENT __ATOMIC_RELAXED, __HIP_MEMORY_SCOPE_AGENT
#define XB_TMO      128
#define XB_XCNT(j)  (256  + 64 * (j))
#define XB_XSUB(j)  (1280 + 64 * (j))
#define XB_XGEN(j)  (2304 + 64 * (j))
#define XB_TOP      3328
#define XB_TOPGEN   3392
#define XCD_BAR_WORDS 3456
#define XB_SPIN_CAP (1u << 18)

__device__ __forceinline__ unsigned xb_ld(unsigned* p)              { return __hip_atomic_load(p, __ATOMIC_RELAXED, __HIP_MEMORY_SCOPE_AGENT); }
__device__ __forceinline__ unsigned xb_add(unsigned* p, unsigned v) { return __hip_atomic_fetch_add(p, v, __ATOMIC_RELAXED, __HIP_MEMORY_SCOPE_AGENT); }
__device__ __forceinline__ unsigned xb_xcc_id() { return (unsigned)__builtin_amdgcn_s_getreg((3 << 11) | 20) & 0xFu; }
#define XB_SPIN(cond, bar) do { unsigned _sp = 0; while (cond) { __builtin_amdgcn_s_sleep(1); \
    if ((++_sp & 255u) == 0u) { if (xb_ld(&(bar)[XB_TMO])) break; if (_sp > XB_SPIN_CAP) { atomicAdd(&(bar)[XB_TMO], 1u); break; } } } } while (0)

struct XcdBarrier {
    unsigned* bar; unsigned x;
    volatile LAS unsigned* st;
};

__device__ __forceinline__ XcdBarrier xcd_barrier_post(unsigned* bar, volatile LAS unsigned* st) {
    XcdBarrier b; b.bar = bar; b.x = xb_xcc_id(); b.st = st;
    if (threadIdx.x == 0) (void)xb_add(&bar[XB_XCNT(b.x)], 1u);
    return b;
}
__device__ __forceinline__ void xcd_barrier_complete(unsigned* bar, unsigned x, unsigned& nloc, unsigned& nx) {
    const unsigned G = gridDim.x * gridDim.y * gridDim.z;
    unsigned sum, cnt, mine, sp = 0u;
    for (;;) {
        sum = 0u; cnt = 0u; mine = 0u;
#pragma unroll
        for (unsigned j = 0; j < 16; ++j) { const unsigned c = xb_ld(&bar[XB_XCNT(j)]); sum += c; cnt += (c > 0u) ? 1u : 0u; mine = (j == x) ? c : mine; }
        if (sum == G) break;
        __builtin_amdgcn_s_sleep(1);
        if ((++sp & 255u) == 0u) { if (xb_ld(&bar[XB_TMO])) break; if (sp > XB_SPIN_CAP) { atomicAdd(&bar[XB_TMO], 1u); break; } }
    }
    nloc = mine > 0u ? mine : 1u; nx = cnt > 0u ? cnt : 1u;
}

__device__ __forceinline__ void xcd_barrier(const XcdBarrier& b) {
    asm volatile("s_waitcnt vmcnt(0)" ::: "memory");
    __syncthreads();
    if (threadIdx.x == 0) {
        unsigned* bar = b.bar;
        __builtin_amdgcn_s_waitcnt(0);
        unsigned nloc = b.st[0], nx = b.st[1];
        if (nloc == 0u) { xcd_barrier_complete(bar, b.x, nloc, nx); b.st[0] = nloc; b.st[1] = nx; }
        const unsigned old = xb_add(&bar[XB_XSUB(b.x)], 1u);
        const unsigned gen = old / nloc;
        if (old + 1u == (gen + 1u) * nloc) {
            __builtin_amdgcn_fence(__ATOMIC_RELEASE, "agent");
            asm volatile("s_waitcnt vmcnt(0)" ::: "memory");
            const unsigned og = xb_add(&bar[XB_TOP], 1u);
            const unsigned tg = og / nx;
            if (og + 1u == (tg + 1u) * nx) xb_add(&bar[XB_TOPGEN], 1u);
            else XB_SPIN(xb_ld(&bar[XB_TOPGEN]) == tg, bar);
            __builtin_amdgcn_fence(__ATOMIC_ACQUIRE, "agent");
            xb_add(&bar[XB_XGEN(b.x)], 1u);
            asm volatile("s_waitcnt vmcnt(0)" ::: "memory");
        } else {
            XB_SPIN(xb_ld(&bar[XB_XGEN(b.x)]) == gen, bar);
            __builtin_amdgcn_fence(__ATOMIC_ACQUIRE, "agent");
            asm volatile("s_waitcnt vmcnt(0)" ::: "memory");
        }
    }
    __syncthreads();
}

#ifndef PROBE_SYNC
#define PROBE_SYNC 0
#endif
#ifndef PROBE_REP_PRO
#define PROBE_REP_PRO 1
#endif
#ifndef PROBE_REP_G1
#define PROBE_REP_G1 1
#endif
#ifndef PROBE_REP_G2
#define PROBE_REP_G2 1
#endif
#ifndef PROBE_REP_G3
#define PROBE_REP_G3 1
#endif
#ifndef PROBE_REP_G4
#define PROBE_REP_G4 1
#endif
#ifndef PROBE_REP_MIXE
#define PROBE_REP_MIXE 1
#endif
#ifndef PROBE_REP_MIXO
#define PROBE_REP_MIXO 1
#endif
__global__ void __launch_bounds__(NTHREADS, 2) fwd_megakernel(Params p_) {
    extern __shared__ __attribute__((aligned(16))) unsigned char lds_raw[];
    const int ph_lo = p_.ph_lo, ph_hi = p_.ph_hi;
    if (threadIdx.x < 2) ((LAS unsigned*)((LAS unsigned char*)lds_raw + LDS_MISC))[threadIdx.x] = 0u;
    __syncthreads();
    (void)xcd_barrier_post((unsigned*)(p_.ws + WS_CTL), (volatile LAS unsigned*)((LAS unsigned char*)lds_raw + LDS_MISC));
    int rr = 0, nsync = 0;
    for (int ph = ph_lo; ph < ph_hi;) {
        if (ph > ph_lo || rr > 0) {
            if (ph_hi < 0) cg::this_grid().sync();
            { XcdBarrier b; b.bar = (unsigned*)(p_.ws + WS_CTL); b.x = xb_xcc_id(); b.st = (volatile LAS unsigned*)((LAS unsigned char*)lds_raw + LDS_MISC); xcd_barrier(b); }
            ++nsync;
        }
#if PROBE_SYNC
        { XcdBarrier b; b.bar = (unsigned*)(p_.ws + WS_CTL); b.x = xb_xcc_id(); b.st = (volatile LAS unsigned*)((LAS unsigned char*)lds_raw + LDS_MISC); xcd_barrier(b); }
#endif
        int zero; asm volatile("s_mov_b32 %0, 0" : "=s"(zero));
        PP p = (PP)((const __attribute__((address_space(4))) char*)__builtin_amdgcn_kernarg_segment_ptr() + zero);
        LAS unsigned char* lds = (LAS unsigned char*)lds_raw;
        int tid_; asm volatile("v_mov_b32 %0, %1" : "=v"(tid_) : "v"((int)threadIdx.x));
        const int tid = tid_, lane = tid & 63, wave = __builtin_amdgcn_readfirstlane(tid >> 6);
        const int G = gridDim.x, bx = blockIdx.x + zero;
        const int gw = bx * NWAVES + wave, NGW = G * NWAVES;
        unsigned char* ws = p->ws;
        bf16* XN = (bf16*)(ws + WS_XN); bf16* HB = (bf16*)(ws + WS_HB); bf16* PROJ = (bf16*)(ws + WS_PROJ); bf16* FB = (bf16*)(ws + WS_F); bf16* MIX = (bf16*)(ws + WS_MIX);
        if (ph == 0) {
            prologue_weights(p, lds, gw, NGW, wave, lane);
            prologue_rope(p, bx * NTHREADS + tid, G * NTHREADS);
            row_pass(p->x, (float*)FB, nullptr, 0.f, nullptr, p->norm_g, XN, gw, NGW, lane);
            __syncthreads();
            if (++rr >= PROBE_REP_PRO) { rr = 0; ++ph; }
            continue;
        }
        const int L = (ph - 1) / 7, s = (ph - 1) % 7;
        const unsigned char* wl = ws + WS_W + (size_t)L * WL_BYTES;
        const bool even = (L & 1) == 0; const int li = L >> 1;
        if (s == 3) {
            unsigned* qctr = (unsigned*)(ws + WS_CTL + CTL_Q) + 64 * L;
            volatile LAS unsigned* qslot = (volatile LAS unsigned*)(lds + LDS_MISC + 16);
            const int total = even ? 1024 : 640;
            for (;;) {
                if (tid == 0) *qslot = __hip_atomic_fetch_add(qctr, 1u, __ATOMIC_RELAXED, __HIP_MEMORY_SCOPE_AGENT);
                __syncthreads();
                const int idx = __builtin_amdgcn_readfirstlane((int)*qslot);
                __syncthreads();
                if (idx >= total) break;
                int tq_; asm volatile("v_mov_b32 %0, %1" : "=v"(tq_) : "v"(tid));
                const int tq = tq_;
                if (even) {
                    if (idx < 512) { const int j = 7 - (idx >> 6), bh = idx & 63; mx::moba_unit(lds, PROJ, MIX, bh >> 3, bh & 7, j, tq); }
                    else mx::conv_item(lds, PROJ, MIX, p->conv_w + (size_t)li * 31 * 512, p->conv_b + li * 512, p->conv_ln_g + li * 512, p->conv_ln_b + li * 512, idx - 512, tq);
                } else {
                    if (idx < 128) mx::sgu_item(lds, PROJ, MIX, p->sgu_ln_g + li * 512, p->sgu_ln_b + li * 512, p->sgu_w + (size_t)li * 4 * 128 * 128, p->sgu_b + li * 4 * 128, idx, tq);
                    else { const int u = idx - 128, jq = 7 - (u >> 6), bh = u & 63; mx::sb_unit(lds, PROJ, MIX, bh >> 3, bh & 7, jq, tq); }
                }
            }
        } else {
            const bf16* A; size_t wo; int N, K; bf16* O = nullptr; int ldc = 0, rc = 0, sw = 0, fm = 0;
            const float* ng = p->norm_g + (size_t)L * 6 * D;
            pg8::FusedNorm fn{}; fn.xb = FB; fn.fout = nullptr; fn.slots1 = (float*)(ws + WS_SLOT1); fn.slots2 = (float*)(ws + WS_SLOT2);
            fn.cnt1 = (unsigned*)(ws + WS_CTL + CTL_CNT1); fn.cnt2 = (unsigned*)(ws + WS_CTL + CTL_CNT2);
            if (s == 0 || s == 5) { A = XN; wo = (s == 0 ? WL_GU0 : WL_GU1); N = 2 * FF; K = D; O = HB; ldc = FF; sw = 1; }
            else if (s == 1 || s == 6) { A = HB; wo = (s == 1 ? WL_D0 : WL_D1); N = D; K = FF; fm = 1; fn.coef = 0.5f; fn.g_post = ng + (s == 1 ? 1 : 5) * D; fn.g_pre = ng + (s == 1 ? 2 : 6) * D;
                fn.xn = XN; fn.fout = (s == 6 && L == DEPTH - 1) ? p->out : nullptr; fn.target = 32u * (unsigned)(3 * L + (s == 1 ? 1 : 3)); }
            else if (s == 2) { A = XN; wo = WL_IN; N = NPROJ; K = D; O = PROJ; ldc = NPROJ; rc = even ? 1024 : 0; }
            else { A = MIX; wo = WL_OUT; N = D; K = D; fm = 1; fn.coef = 1.0f; fn.g_post = ng + 3 * D; fn.g_pre = ng + 4 * D; fn.xn = XN; fn.target = 32u * (unsigned)(3 * L + 2); }
            pg8::Gemm g{A, (const bf16*)(wl + wo), M, N, K}; pg8::StaticOrder S; S.init(M, N, G, bx);
            pg8::EpiUni E{O, ldc, (const float*)(ws + WS_ROPE), rc, sw, fm, fn};
            pg8::gemm_phase<pg8::EpiUni, pg8::StaticOrder, true, true>(lds, g, S, E, tid);
            if ((s == 0 || s == 2 || s == 5) && bx >= 128 && G == 256) {
                int tq_; asm volatile("v_mov_b32 %0, %1" : "=v"(tq_) : "v"(tid));
                const int lq = tq_ & 63, wq = __builtin_amdgcn_readfirstlane(tq_ >> 6);
                int ra, na, Lb = L, rb, nb;
                if (s == 0) { ra = 5632; na = 176; rb = 8448; nb = 160; }
                else if (s == 2) { ra = 9728; na = 64; rb = 2816; nb = 352; }
                else { ra = 7040; na = 176; Lb = L + 1; rb = 0; nb = (L < DEPTH - 1) ? 352 : 0; }
                for (int w = bx - 128; w < na + nb; w += 128) { const bool first = w < na;
                    convert_wave_item(p, first ? L : Lb, (first ? ra + w * 8 : rb + (w - na) * 8) + wq, (LAS float*)(lds + wq * 16384), lq); }
                __syncthreads();
            }
        }
        { const int reps = (s == 0 || s == 5) ? PROBE_REP_G1 : s == 2 ? PROBE_REP_G3 : 1;
          if (++rr >= reps) { rr = 0; ++ph; } }
    }
}
constexpr int N_PHASES = 1 + 7 * DEPTH;

#ifndef MK_PER_PHASE
#define MK_PER_PHASE 0
#endif
extern "C" void kernel_launch(void* const* d_in, const int* in_sizes, int n_in, void* d_out, int out_size, void* d_ws, size_t ws_size, hipStream_t stream) {
    static int grid = 0;
    if (grid == 0) {
        if (n_in != 17 || out_size != M * D || ws_size < WS_END) { fprintf(stderr, "kernel_launch: unexpected shapes (n_in %d out %d ws %zu)\n", n_in, out_size, ws_size); grid = -1; return; }
        int dev = 0, cus = 0, per_cu = 0;
        hipGetDevice(&dev); hipDeviceGetAttribute(&cus, hipDeviceAttributeMultiprocessorCount, dev);
        if (hipFuncSetAttribute((const void*)fwd_megakernel, hipFuncAttributeMaxDynamicSharedMemorySize, LDS_BYTES) != hipSuccess) { fprintf(stderr, "kernel_launch: hipFuncSetAttribute failed\n"); grid = -1; return; }
        if (hipOccupancyMaxActiveBlocksPerMultiprocessor(&per_cu, (const void*)fwd_megakernel, NTHREADS, LDS_BYTES) != hipSuccess || per_cu < 1) { fprintf(stderr, "kernel_launch: occupancy query says %d\n", per_cu); per_cu = 1; }
        (void)hipGetLastError();
        grid = cus * 1;
    }
    if (grid < 0) return;
    if (hipMemsetAsync((unsigned char*)d_ws + WS_CTL, 0, CTL_BYTES, stream) != hipSuccess) { fprintf(stderr, "kernel_launch: memset of the barrier words failed\n"); return; }
    Params p{};
    p.x = (const float*)d_in[0]; p.norm_g = (const float*)d_in[1]; p.w_gate = (const float*)d_in[2]; p.w_up = (const float*)d_in[3]; p.w_down = (const float*)d_in[4];
    p.ab_w_in = (const float*)d_in[5]; p.ab_w_out = (const float*)d_in[6]; p.conv_w = (const float*)d_in[7]; p.conv_b = (const float*)d_in[8]; p.conv_ln_g = (const float*)d_in[9]; p.conv_ln_b = (const float*)d_in[10];
    p.cd_w_in = (const float*)d_in[11]; p.cd_w_out = (const float*)d_in[12]; p.sgu_ln_g = (const float*)d_in[13]; p.sgu_ln_b = (const float*)d_in[14]; p.sgu_w = (const float*)d_in[15]; p.sgu_b = (const float*)d_in[16];
    p.out = (float*)d_out; p.ws = (unsigned char*)d_ws;
    for (int i = 0; i < 32; ++i) p.inv_freq[i] = powf(10000.0f, -(float)(2 * i) / 64.0f);
#if MK_PER_PHASE
    for (int ph = 0; ph < N_PHASES; ++ph) { p.ph_lo = ph; p.ph_hi = ph + 1; hipLaunchKernelGGL(fwd_megakernel, dim3(grid), dim3(NTHREADS), LDS_BYTES, stream, p); }
#else
    p.ph_lo = 0; p.ph_hi = N_PHASES;
    void* args[] = {&p};
    hipError_t e = hipLaunchCooperativeKernel((const void*)fwd_megakernel, dim3(grid), dim3(NTHREADS), args, LDS_BYTES, stream);
    if (e != hipSuccess) fprintf(stderr, "cooperative launch failed: %s (grid %d)\n", hipGetErrorString(e), grid);
#endif
}
```
